# Optimizing an MI355X kernel written in HIP

```python
import jax, jax.numpy as jnp
from jax import lax
import numpy as np

D_MODEL = 1024
BATCH = 16
SEQ = 2048
DEPTH = 1

PLE_DIM = 256
RMS_EPS = 1e-6
DN_HEADS = 4
DN_DK = 128
DN_DV = 128
DN_CONV = 4
DN_CHUNK = 64
DN_QK = DN_HEADS * DN_DK
DN_V = DN_HEADS * DN_DV
DN_CONV_CH = 2 * DN_QK + DN_V
SA_HEADS = 8
SA_HEAD_DIM = 64
SA_QBLOCK = 128
IDX_HEADS = 4
IDX_DIM = 64
IDX_TOPK_MAX = 256
ROPE_THETA = 500000.0
ROPE_FRACTION = 4
NEG_INF = -1e30
D_FF = ((8 * D_MODEL + 3 * 256 - 1) // (3 * 256)) * 256
IN_SPLIT_SIZES = (DN_CONV_CH, DN_V, DN_HEADS, DN_HEADS,
                  SA_HEADS * SA_HEAD_DIM, SA_HEAD_DIM, SA_HEAD_DIM,
                  IDX_HEADS * IDX_DIM, IDX_DIM, IDX_HEADS)
D_IN = sum(IN_SPLIT_SIZES)

kernel_name = 'hybrid_gdn_dsa_gated_merge_block'


def rmsnorm(x, g, eps=RMS_EPS):
    xf = x.astype(jnp.float32)
    y = xf * lax.rsqrt(jnp.mean(xf * xf, axis=-1, keepdims=True) + eps)
    return (y * g.astype(jnp.float32)).astype(x.dtype)


def l2norm(x, eps=1e-6):
    return x * lax.rsqrt(jnp.sum(x * x, axis=-1, keepdims=True) + eps)


def rope_tables(positions, rot_dim):
    inv_freq = ROPE_THETA ** (-jnp.arange(0, rot_dim, 2, dtype=jnp.float32) / rot_dim)
    ang = positions.astype(jnp.float32)[..., None] * inv_freq
    return jnp.cos(ang), jnp.sin(ang)


def apply_partial_rope(x, cos, sin):
    half = cos.shape[-1]
    xf = x.astype(jnp.float32)
    x1, x2, rest = xf[..., :half], xf[..., half:2 * half], xf[..., 2 * half:]
    out = jnp.concatenate([x1 * cos - x2 * sin, x2 * cos + x1 * sin, rest], axis=-1)
    return out.astype(x.dtype)


def causal_depthwise_conv(x, w):
    k = w.shape[0]
    return lax.conv_general_dilated(
        x, w[:, None, :].astype(x.dtype), window_strides=(1,), padding=[(k - 1, 0)],
        dimension_numbers=('NWC', 'WIO', 'NWC'), feature_group_count=x.shape[-1])


def chunk_gated_delta_rule(q, k, v, g, beta):
    B, S, H, DK = q.shape
    DV = v.shape[-1]
    C = DN_CHUNK
    N = S // C
    q = q * (DK ** -0.5)

    def chunk(t):
        return t.reshape(B, N, C, H, t.shape[-1]).transpose(0, 1, 3, 2, 4)

    qc, kc, vc = chunk(q), chunk(k), chunk(v)
    gc = jnp.cumsum(g.reshape(B, N, C, H).transpose(0, 1, 3, 2), axis=-1)
    bc = beta.reshape(B, N, C, H).transpose(0, 1, 3, 2)
    lower = jnp.tril(jnp.ones((C, C), dtype=bool))
    strict = jnp.tril(jnp.ones((C, C), dtype=bool), k=-1)
    diff = gc[..., :, None] - gc[..., None, :]
    decay = jnp.where(lower, jnp.exp(jnp.minimum(diff, 0.0)), 0.0)
    kb = kc * bc[..., None]
    lmat = jnp.where(strict, jnp.einsum('bnhcd,bnhed->bnhce', kb, kc) * decay, 0.0)
    amat = lmat + jnp.eye(C, dtype=jnp.float32)
    rhs = jnp.concatenate([vc * bc[..., None], kb * jnp.exp(gc)[..., None]], axis=-1)
    sol = lax.linalg.triangular_solve(amat, rhs, left_side=True, lower=True,
                                      transpose_a=False, conjugate_a=False, unit_diagonal=True)
    u, w = sol[..., :DV], sol[..., DV:]
    intra = jnp.where(lower, jnp.einsum('bnhcd,bnhed->bnhce', qc, kc) * decay, 0.0)

    def step(state, xs):
        q_i, k_i, u_i, w_i, g_i, a_i = xs
        v_new = u_i - jnp.einsum('bhcd,bhde->bhce', w_i, state)
        o = (jnp.einsum('bhcd,bhde->bhce', q_i * jnp.exp(g_i)[..., None], state)
             + jnp.einsum('bhce,bhef->bhcf', a_i, v_new))
        g_last = g_i[..., -1]
        k_dec = k_i * jnp.exp(g_last[..., None] - g_i)[..., None]
        state = state * jnp.exp(g_last)[..., None, None] + jnp.einsum('bhcd,bhce->bhde', k_dec, v_new)
        return state, o

    xs = tuple(jnp.moveaxis(t, 1, 0) for t in (qc, kc, u, w, gc, intra))
    state0 = jnp.zeros((B, H, DK, DV), jnp.float32)
    _, o = lax.scan(step, state0, xs)
    return o.transpose(1, 0, 3, 2, 4).reshape(B, S, H, DV)


def gated_deltanet(qkv, z, b, a, conv_w, a_log, dt_bias, norm_g):
    B, S, _ = qkv.shape
    qkv = jax.nn.silu(causal_depthwise_conv(qkv, conv_w)).astype(jnp.float32)
    q = l2norm(qkv[..., :DN_QK].reshape(B, S, DN_HEADS, DN_DK))
    k = l2norm(qkv[..., DN_QK:2 * DN_QK].reshape(B, S, DN_HEADS, DN_DK))
    v = qkv[..., 2 * DN_QK:].reshape(B, S, DN_HEADS, DN_DV)
    beta = jax.nn.sigmoid(b.astype(jnp.float32))
    g = -jnp.exp(a_log.astype(jnp.float32)) * jax.nn.softplus(a.astype(jnp.float32) + dt_bias.astype(jnp.float32))
    o = chunk_gated_delta_rule(q, k, v, g, beta)
    zf = z.astype(jnp.float32).reshape(B, S, DN_HEADS, DN_DV)
    o = rmsnorm(o, norm_g) * jax.nn.silu(zf)
    return o.reshape(B, S, DN_V).astype(z.dtype)


def dsa_sparse_attention(q, k, v, qi, ki, wi, topk):
    B, S, H, D = q.shape
    nb = S // SA_QBLOCK
    kv = jnp.concatenate([k, v], axis=-1)
    wi = wi.astype(jnp.float32) * (IDX_HEADS ** -0.5) * (IDX_DIM ** -0.5)
    key_pos = jnp.arange(S, dtype=jnp.int32)

    def blocks(t):
        return jnp.moveaxis(t.reshape((B, nb, SA_QBLOCK) + t.shape[2:]), 1, 0)

    def one_block(args):
        qb, qib, wb, start = args
        qpos = start + jnp.arange(SA_QBLOCK, dtype=jnp.int32)
        causal = key_pos[None, None, :] <= qpos[None, :, None]
        logits = jnp.einsum('bqhd,bsd->bqhs', qib, ki).astype(jnp.float32)
        score = jnp.einsum('bqhs,bqh->bqs', jax.nn.relu(logits), wb)
        score = jnp.where(causal, score, NEG_INF)
        _, idx = lax.top_k(score, topk)
        valid = idx <= qpos[None, :, None]
        kv_sel = jax.vmap(lambda tab, ix: tab[ix])(kv, idx)
        k_sel, v_sel = kv_sel[..., :D], kv_sel[..., D:]
        att = jnp.einsum('bqhd,bqkd->bqhk', qb, k_sel).astype(jnp.float32) * (D ** -0.5)
        att = jnp.where(valid[:, :, None, :], att, NEG_INF)
        prob = jax.nn.softmax(att, axis=-1).astype(v_sel.dtype)
        return jnp.einsum('bqhk,bqkd->bqhd', prob, v_sel)

    starts = jnp.arange(nb, dtype=jnp.int32) * SA_QBLOCK
    out = lax.map(one_block, (blocks(q), blocks(qi), blocks(wi), starts))
    return jnp.moveaxis(out, 0, 1).reshape(B, S, H * D)


def setup_inputs(seed: int = 0) -> dict:
    key = jax.random.key(seed)
    ks = jax.random.split(key, 24)
    f32 = jnp.float32

    def dense(k, fan_in, fan_out):
        return jax.random.normal(k, (DEPTH, fan_in, fan_out), f32) * (fan_in ** -0.5)

    def gain(k, n):
        return 1.0 + 0.01 * jax.random.normal(k, (DEPTH, n), f32)

    x = jax.random.normal(ks[0], (BATCH, SEQ, D_MODEL), f32)
    p = jax.random.normal(ks[1], (DEPTH, BATCH, SEQ, PLE_DIM), f32)
    positions = jnp.broadcast_to(jnp.arange(SEQ, dtype=jnp.int32), (BATCH, SEQ))
    dt = jnp.exp(jax.random.uniform(ks[6], (DEPTH, DN_HEADS), f32, jnp.log(0.001), jnp.log(0.1)))
    return {
        'x': x,
        'p': p,
        'positions': positions,
        'attn_norm': gain(ks[2], D_MODEL),
        'w_in': dense(ks[3], D_MODEL, D_IN),
        'conv_w': jax.random.normal(ks[4], (DEPTH, DN_CONV, DN_CONV_CH), f32) * (DN_CONV ** -0.5),
        'a_log': jnp.log(jax.random.uniform(ks[5], (DEPTH, DN_HEADS), f32, 1.0, 16.0)),
        'dt_bias': dt + jnp.log(-jnp.expm1(-dt)),
        'dn_norm': gain(ks[7], DN_DV),
        'q_norm': gain(ks[8], SA_HEAD_DIM),
        'k_norm': gain(ks[9], SA_HEAD_DIM),
        'w_branch_a': dense(ks[10], DN_V, D_MODEL),
        'w_branch_b': dense(ks[11], SA_HEADS * SA_HEAD_DIM, D_MODEL),
        'w_gate': dense(ks[12], D_MODEL, 2 * D_MODEL),
        'b_gate': 0.01 * jax.random.normal(ks[13], (DEPTH, 2 * D_MODEL), f32),
        'w_o': dense(ks[14], D_MODEL, D_MODEL),
        'ffn_norm': gain(ks[15], D_MODEL),
        'w_ffn_gate': dense(ks[16], D_MODEL, D_FF),
        'w_ffn_up': dense(ks[17], D_MODEL, D_FF),
        'w_ffn_down': dense(ks[18], D_FF, D_MODEL),
        'ple_norm': gain(ks[19], D_MODEL),
        'w_ple_gate': dense(ks[20], D_MODEL, D_MODEL),
        'w_ple': dense(ks[21], PLE_DIM, D_MODEL),
    }


def reference(x, p, positions, attn_norm, w_in, conv_w, a_log, dt_bias, dn_norm, q_norm, k_norm,
              w_branch_a, w_branch_b, w_gate, b_gate, w_o, ffn_norm, w_ffn_gate, w_ffn_up,
              w_ffn_down, ple_norm, w_ple_gate, w_ple):
    B, S, _ = x.shape
    topk = min(IDX_TOPK_MAX, S // 4)
    cos_a, sin_a = rope_tables(positions, SA_HEAD_DIM // ROPE_FRACTION)
    cos_i, sin_i = rope_tables(positions, IDX_DIM // ROPE_FRACTION)
    offsets = np.cumsum(IN_SPLIT_SIZES)[:-1].tolist()
    for i in range(DEPTH):
        h = rmsnorm(x, attn_norm[i])
        proj = h @ w_in[i].astype(h.dtype)
        (dn_qkv, dn_z, dn_b, dn_a, sa_q, sa_k, sa_v, ix_q, ix_k, ix_w) = jnp.split(proj, offsets, axis=-1)
        o_a = gated_deltanet(dn_qkv, dn_z, dn_b, dn_a, conv_w[i], a_log[i], dt_bias[i], dn_norm[i])
        q = rmsnorm(sa_q.reshape(B, S, SA_HEADS, SA_HEAD_DIM), q_norm[i])
        q = apply_partial_rope(q, cos_a[:, :, None, :], sin_a[:, :, None, :])
        k = apply_partial_rope(rmsnorm(sa_k, k_norm[i]), cos_a, sin_a)
        qi = apply_partial_rope(ix_q.reshape(B, S, IDX_HEADS, IDX_DIM), cos_i[:, :, None, :], sin_i[:, :, None, :])
        ki = apply_partial_rope(ix_k, cos_i, sin_i)
        o_b = dsa_sparse_attention(q, k, sa_v, qi, ki, ix_w, topk)
        y_a = o_a @ w_branch_a[i].astype(o_a.dtype)
        y_b = o_b @ w_branch_b[i].astype(o_b.dtype)
        gates = jax.nn.sigmoid(h @ w_gate[i].astype(h.dtype) + b_gate[i].astype(h.dtype))
        g_a, g_b = gates[..., :D_MODEL], gates[..., D_MODEL:]
        x = x + (g_a * y_a + g_b * y_b) @ w_o[i].astype(x.dtype)
        h2 = rmsnorm(x, ffn_norm[i])
        ff = jax.nn.silu(h2 @ w_ffn_gate[i].astype(h2.dtype)) * (h2 @ w_ffn_up[i].astype(h2.dtype))
        x = x + ff @ w_ffn_down[i].astype(ff.dtype)
        ple_g = jax.nn.sigmoid(rmsnorm(x, ple_norm[i]) @ w_ple_gate[i].astype(x.dtype))
        x = x + ple_g * (p[i].astype(x.dtype) @ w_ple[i].astype(x.dtype))
    return x
```

```cpp
#include <hip/hip_runtime.h>
#include <hip/hip_cooperative_groups.h>
#include <cstdio>
namespace cg = cooperative_groups;
namespace pg8 {
#define PG8_LAS __attribute__((address_space(3)))
typedef unsigned short bf16_t;
typedef short bf16x8 __attribute__((ext_vector_type(8)));
typedef float f32x4 __attribute__((ext_vector_type(4)));
typedef unsigned u32x4 __attribute__((ext_vector_type(4)));
constexpr int BM = 256, BK = 64, HALF = 128, HTB = HALF * BK * 2  , STAGE_BYTES = 8 * HTB, NXCD = 8, WGM = 8;

__host__ __device__ __forceinline__ int lds_byte(int r, int c) { const int st = (r >> 4) * 2 + (c >> 5), rr = r & 15, cc = c & 31, ob = rr * 64 + cc * 2; return st * 1024 + (ob ^ (((ob >> 9) & 1) << 5)); }
__host__ __device__ __forceinline__ void stage_rc(int b, int& R, int& C) { const int st = b / 1024, sb = b % 1024, swz = sb ^ (((sb >> 9) & 1) << 5); R = (st >> 1) * 16 + swz / 64; C = (st & 1) * 32 + (swz % 64) / 2; }
__host__ __device__ __forceinline__ int perm32(int rho) { const int n = rho >> 4, i = rho & 15; return 8 * (i >> 2) + 4 * n + (i & 3); }

struct Unit { int pm, pn; };
struct Gemm { const bf16_t* A; const bf16_t* Bt; int M, N, K; };

struct StaticOrder {
    int nM, nN, nwg, G, c;
    __host__ __device__ void init(int M, int N, int G_, int c_) { nM = M / BM; nN = N / BM; nwg = nM * nN; G = G_; c = c_; }
    __host__ __device__ bool next(int i, Unit& u) const {
        const long L = (long)i * G + c; if (L >= nwg) return false;
        int wgid = (int)L; { const int q = nwg / NXCD, r = nwg % NXCD, xcd = wgid % NXCD, off = wgid / NXCD; wgid = (xcd < r ? xcd * (q + 1) : r * (q + 1) + (xcd - r) * q) + off; }
        const int nig = WGM * nN, gid = wgid / nig, fm = gid * WGM, gsz = (nM - fm) < WGM ? (nM - fm) : WGM;
        u.pm = fm + ((wgid % nig) % gsz); u.pn = (wgid % nig) / gsz; return true;
    }
    __device__ __forceinline__ void a_ready(const Unit&) const {}
    __device__ __forceinline__ void done(const Unit&) const {}
};
__device__ __forceinline__ unsigned cvt_pk_bf16(float lo, float hi) { unsigned r; asm volatile("v_cvt_pk_bf16_f32 %0, %1, %2" : "=v"(r) : "v"(lo), "v"(hi)); return r; }
typedef float f32x2 __attribute__((ext_vector_type(2)));
template <class Epi, class Sched>
__device__ __forceinline__ void gemm_phase(PG8_LAS unsigned char* lds, const Gemm g, const Sched& S, const Epi& E) {
    const int tid = threadIdx.x, wid = __builtin_amdgcn_readfirstlane(tid >> 6), lane = tid & 63, wr = wid >> 2, wc = wid & 3, fr = lane & 15, fq = lane >> 4;
    const int K = g.K, nt = K / BK;
    unsigned voffA[2], voffB[2];
#pragma unroll
    for (int i = 0; i < 2; ++i) { int R, C; stage_rc(tid * 16 + i * 8192, R, C); const int Rb = Epi::PERM ? ((R & ~31) + perm32(R & 31)) : R;
        voffA[i] = (unsigned)(R * K + C) * 2u; voffB[i] = (unsigned)(Rb * K + C) * 2u; }
    const size_t kstep = (size_t)(BK * 2);
    const size_t hstep = (size_t)HALF * K * 2;
    const size_t tstep = 2 * hstep;
    const unsigned ldsw = (unsigned)wid * 1024u;
    const int aoff = lds_byte(wr * 64 + fr, fq * 8), boff = lds_byte(wc * 32 + fr, fq * 8);
#define PG8_SA(b, h) (((b) * 2 + (h)) * HTB)
#define PG8_SB(b, h) ((4 + (b) * 2 + (h)) * HTB)
#define PG8_STAGE(bufoff, gbase, voff) do { _Pragma("unroll") for (int _i = 0; _i < 2; ++_i) \
        __builtin_amdgcn_global_load_lds((const unsigned*)((const char*)(gbase) + (voff)[_i]), (PG8_LAS unsigned*)(lds + (bufoff) + ldsw + _i * 8192), 16, 0, 0); } while (0)
#define PG8_LDA(dst, b, h) do { _Pragma("unroll") for (int m = 0; m < 4; ++m) _Pragma("unroll") for (int k = 0; k < 2; ++k) dst[m][k] = *(const PG8_LAS bf16x8*)(lds + PG8_SA(b, h) + aoff + m * 2048 + k * 1024); } while (0)
#define PG8_LDB(dst, b, h) do { _Pragma("unroll") for (int n = 0; n < 2; ++n) _Pragma("unroll") for (int k = 0; k < 2; ++k) dst[n][k] = *(const PG8_LAS bf16x8*)(lds + PG8_SB(b, h) + boff + n * 2048 + k * 1024); } while (0)
#define PG8_MMA(ai, bj, At, Bt) do { __builtin_amdgcn_s_setprio(1); _Pragma("unroll") for (int m = 0; m < 4; ++m) _Pragma("unroll") for (int n = 0; n < 2; ++n) _Pragma("unroll") for (int k = 0; k < 2; ++k) \
        acc[ai][bj][m][n] = __builtin_amdgcn_mfma_f32_16x16x32_bf16(Bt[n][k], At[m][k], acc[ai][bj][m][n], 0, 0, 0); __builtin_amdgcn_s_setprio(0); } while (0)
#define PG8_WAIT_V(n) asm volatile("s_waitcnt vmcnt(" #n ")" ::: "memory")
#define PG8_WAIT_L(n) asm volatile("s_waitcnt lgkmcnt(" #n ")" ::: "memory")
#define PG8_BAR __builtin_amdgcn_s_barrier()
#define PG8_SCHED __builtin_amdgcn_sched_barrier(0)
    Unit cur, nxt; int ui = 0;
    if (!S.next(0, cur)) return;
    f32x4 acc[2][2][4][2];
#pragma unroll
    for (int a = 0; a < 2; ++a)
#pragma unroll
        for (int b = 0; b < 2; ++b)
#pragma unroll
            for (int m = 0; m < 4; ++m)
#pragma unroll
                for (int n = 0; n < 2; ++n) acc[a][b][m][n] = (f32x4){0.f, 0.f, 0.f, 0.f};
    bf16x8 At[4][2], B0[2][2], B1[2][2];
    const char* cA = (const char*)g.A + (size_t)cur.pm * tstep; const char* cB = (const char*)g.Bt + (size_t)cur.pn * tstep;
    S.a_ready(cur);
    PG8_STAGE(PG8_SB(0, 0), cB, voffB); PG8_STAGE(PG8_SA(0, 0), cA, voffA); PG8_STAGE(PG8_SB(0, 1), cB + hstep, voffB); PG8_STAGE(PG8_SA(0, 1), cA + hstep, voffA);
    if (wr == 1) PG8_BAR;
    PG8_WAIT_V(4); PG8_BAR;
    PG8_STAGE(PG8_SB(1, 0), cB + kstep, voffB); PG8_STAGE(PG8_SA(1, 0), cA + kstep, voffA); PG8_STAGE(PG8_SB(1, 1), cB + hstep + kstep, voffB);
    PG8_WAIT_V(6); PG8_BAR;
    for (;;) {
        const bool has_next = S.next(ui + 1, nxt);
        const char* nA = has_next ? (const char*)g.A + (size_t)nxt.pm * tstep : cA; const char* nB = has_next ? (const char*)g.Bt + (size_t)nxt.pn * tstep : cB;
        for (int t = 0; t < nt; t += 2) {
            const bool last = (t == nt - 2);
            const char* a1 = cA + (size_t)(t + 1) * kstep;
            const char* a2 = last ? nA : cA + (size_t)(t + 2) * kstep; const char* b2 = last ? nB : cB + (size_t)(t + 2) * kstep;
            const char* a3 = a2 + kstep; const char* b3 = b2 + kstep;
            if (last && has_next) S.a_ready(nxt);
            PG8_LDB(B0, 0, 0); PG8_SCHED; PG8_LDA(At, 0, 0); PG8_STAGE(PG8_SA(1, 1), a1 + hstep, voffA);
            PG8_WAIT_L(8); PG8_BAR; PG8_WAIT_L(0); PG8_MMA(0, 0, At, B0); PG8_BAR; PG8_SCHED;
            PG8_LDB(B1, 0, 1); PG8_STAGE(PG8_SB(0, 0), b2, voffB);
            PG8_BAR; PG8_WAIT_L(0); PG8_MMA(0, 1, At, B1); PG8_BAR;
            PG8_LDA(At, 0, 1); PG8_STAGE(PG8_SA(0, 0), a2, voffA);
            PG8_BAR; PG8_WAIT_L(0); PG8_MMA(1, 0, At, B0); PG8_BAR; PG8_SCHED;
            PG8_STAGE(PG8_SB(0, 1), b2 + hstep, voffB);
            PG8_WAIT_V(6); PG8_BAR; PG8_MMA(1, 1, At, B1); PG8_BAR;
            PG8_LDB(B0, 1, 0); PG8_SCHED; PG8_LDA(At, 1, 0); PG8_STAGE(PG8_SA(0, 1), a2 + hstep, voffA);
            PG8_WAIT_L(8); PG8_BAR; PG8_WAIT_L(0); PG8_MMA(0, 0, At, B0); PG8_BAR; PG8_SCHED;
            PG8_LDB(B1, 1, 1); PG8_STAGE(PG8_SB(1, 0), b3, voffB);
            PG8_BAR; PG8_WAIT_L(0); PG8_MMA(0, 1, At, B1); PG8_BAR;
            PG8_LDA(At, 1, 1); PG8_STAGE(PG8_SA(1, 0), a3, voffA);
            PG8_BAR; PG8_WAIT_L(0); PG8_MMA(1, 0, At, B0); PG8_BAR; PG8_SCHED;
            PG8_STAGE(PG8_SB(1, 1), b3 + hstep, voffB);
            PG8_WAIT_V(6); PG8_BAR; PG8_MMA(1, 1, At, B1); PG8_BAR;
        }
        if constexpr (!Epi::AFTER_DRAIN) { E(acc, cur, wr, wc, fr, fq); S.done(cur); }
        if (!has_next) break;
#pragma unroll
        for (int a = 0; a < 2; ++a)
#pragma unroll
            for (int b = 0; b < 2; ++b)
#pragma unroll
                for (int m = 0; m < 4; ++m)
#pragma unroll
                    for (int n = 0; n < 2; ++n) acc[a][b][m][n] = (f32x4){0.f, 0.f, 0.f, 0.f};
        cur = nxt; cA = nA; cB = nB; ++ui;
    }
    PG8_WAIT_V(0);
    if (wr == 0) PG8_BAR;
    PG8_BAR;
    if constexpr (Epi::AFTER_DRAIN) { E.fused(acc, cur, wr, wc, fr, fq, lds, wid, lane); S.done(cur); }
#undef PG8_SA
#undef PG8_SB
#undef PG8_STAGE
#undef PG8_LDA
#undef PG8_LDB
#undef PG8_MMA
#undef PG8_WAIT_V
#undef PG8_WAIT_L
#undef PG8_BAR
#undef PG8_SCHED
}
}
using pg8::bf16_t; using pg8::f32x4; using pg8::u32x4; using pg8::Unit; using pg8::cvt_pk_bf16;
typedef unsigned long long u64;
typedef unsigned u32x2 __attribute__((ext_vector_type(2)));

constexpr int T_TOK = 32768, SEQ = 2048, NB = 16, DM = 1024, DFF = 2816;
constexpr int PROJ_LD = 2688, SIDE_LD = 384;
constexpr size_t MiB = 1ull << 20;
constexpr size_t OFF_BT1 = 0, OFF_BTA = 10 * MiB, OFF_BTB = 11 * MiB, OFF_BTO = 12 * MiB, OFF_BTF = 14 * MiB, OFF_BTD = 25 * MiB, OFF_BTPG = 31 * MiB, OFF_BTP = 33 * MiB,
                 OFF_MISC = 34 * MiB, OFF_BG = 35 * MiB, OFF_R1 = 36 * MiB, OFF_PB = 100 * MiB, OFF_PROJ = 116 * MiB, OFF_SIDE = 284 * MiB, OFF_GATES = 332 * MiB, WS_END = 460 * MiB;
constexpr int LDS_BYTES = 136 * 1024;

struct Params {
    const float *x, *p; const int* pos;
    const float *attn_norm, *w_in, *conv_w, *a_log, *dt_bias, *dn_norm, *q_norm, *k_norm, *w_ba, *w_bb, *w_gate, *b_gate, *w_o, *ffn_norm, *w_fg, *w_fu, *w_fd, *ple_norm, *w_pg, *w_ple;
    float* out; unsigned char* ws;
};

__device__ __forceinline__ float bf2f(unsigned short b) { return __uint_as_float(((unsigned)b) << 16); }
__device__ __forceinline__ unsigned short f2bf(float f) { unsigned u = __float_as_uint(f); u += 0x7FFFu + ((u >> 16) & 1u); return (unsigned short)(u >> 16); }
__device__ __forceinline__ float bflo(unsigned u) { return __uint_as_float(u << 16); }
__device__ __forceinline__ float bfhi(unsigned u) { return __uint_as_float(u & 0xFFFF0000u); }
__device__ __forceinline__ unsigned pack2(float a, float b) { return (unsigned)f2bf(a) | ((unsigned)f2bf(b) << 16); }
__device__ __forceinline__ float sigmoidf_(float v) { return 1.0f / (1.0f + __expf(-v)); }
__device__ __forceinline__ float siluf_(float v) { return v / (1.0f + __expf(-v)); }
__device__ __forceinline__ float wave_sum(float v) {
#pragma unroll
    for (int o = 32; o >= 1; o >>= 1) v += __shfl_xor(v, o);
    return v;
}

__device__ __forceinline__ int win_map(int n) {
    if (n < 2048) return n;
    if (n < 2560) return n + 8;
    if (n < 2688) return n + 8;
    if (n < 2752) return n - 2688 + 2952;
    if (n < 2756) return n - 2752 + 3016;
    if (n < 2764) return n - 2756 + 2048;
    if (n < 2816) return -1;
    return n - 2816 + 2696;
}
struct TJob { int kind; const float* s0; const float* s1; int ld; int K; int N; const float* gain; bf16_t* dst; };
__device__ __forceinline__ void transpose_job(const TJob& j, float* lds  , int& work_i, int first, int stride) {
    const int nkt = j.K / 64, nnt = j.N / 64, ntile = nkt * nnt, tid = threadIdx.x;
    for (int t = 0; t < ntile; ++t, ++work_i) {
        if ((work_i % stride) != first) continue;
        const int kt = t % nkt, ntl = t / nkt, k0 = kt * 64, n0 = ntl * 64;
        __syncthreads();
#pragma unroll
        for (int i = 0; i < 8; ++i) {
            const int k = i * 8 + (tid >> 6), n = tid & 63, dn = n0 + n;
            const float* sp = j.s0; int sc = dn;
            if (j.kind == 0) { if (dn < 3072) sc = win_map(dn); else { sp = j.s1; sc = dn - 3072; } }
            else if (j.kind == 2) { const int tl = dn >> 8, w = dn & 255; if (w < 128) sc = tl * 128 + w; else { sp = j.s1; sc = tl * 128 + w - 128; } }
            const int ld = (j.kind == 0 && dn >= 3072) ? 2048 : j.ld;
            float v = 0.f;
            if (sc >= 0) { v = sp[(size_t)(k0 + k) * ld + sc]; if (j.gain) v *= j.gain[k0 + k]; }
            lds[k * 65 + n] = v;
        }
        __syncthreads();
#pragma unroll
        for (int i = 0; i < 8; ++i) {
            const int n = i * 8 + (tid >> 6), k = tid & 63;
            j.dst[(size_t)(n0 + n) * j.K + k0 + k] = f2bf(lds[k * 65 + n]);
        }
    }
}

__device__ void phase_prep(const Params& P, float* lds) {
    unsigned char* ws = P.ws;
    int wi = 0; const int first = blockIdx.x, stride = gridDim.x;
    { TJob j{0, P.w_in, P.w_gate, 3020, 1024, 5120, P.attn_norm ? nullptr : nullptr, (bf16_t*)(ws + OFF_BT1)}; transpose_job(j, lds, wi, first, stride); }
    { TJob j{1, P.w_ba, nullptr, 1024, 512, 1024, nullptr, (bf16_t*)(ws + OFF_BTA)}; transpose_job(j, lds, wi, first, stride); }
    { TJob j{1, P.w_bb, nullptr, 1024, 512, 1024, nullptr, (bf16_t*)(ws + OFF_BTB)}; transpose_job(j, lds, wi, first, stride); }
    { TJob j{1, P.w_o, nullptr, 1024, 1024, 1024, nullptr, (bf16_t*)(ws + OFF_BTO)}; transpose_job(j, lds, wi, first, stride); }
    { TJob j{2, P.w_fg, P.w_fu, 2816, 1024, 5632, P.ffn_norm, (bf16_t*)(ws + OFF_BTF)}; transpose_job(j, lds, wi, first, stride); }
    { TJob j{1, P.w_fd, nullptr, 1024, 2816, 1024, nullptr, (bf16_t*)(ws + OFF_BTD)}; transpose_job(j, lds, wi, first, stride); }
    { TJob j{1, P.w_pg, nullptr, 1024, 1024, 1024, P.ple_norm, (bf16_t*)(ws + OFF_BTPG)}; transpose_job(j, lds, wi, first, stride); }
    { TJob j{1, P.w_ple, nullptr, 1024, 256, 1024, nullptr, (bf16_t*)(ws + OFF_BTP)}; transpose_job(j, lds, wi, first, stride); }
    const int tid = threadIdx.x, lane = tid & 63, wid = tid >> 6, gw = blockIdx.x * 8 + wid, nw = gridDim.x * 8;
    bf16_t* h = (bf16_t*)(ws + OFF_R1);
    for (int r = gw; r < T_TOK; r += nw) {
        const float4* xr = (const float4*)(P.x + (size_t)r * DM);
        float4 v[4]; float ss = 0.f;
#pragma unroll
        for (int i = 0; i < 4; ++i) { v[i] = xr[i * 64 + lane]; ss += v[i].x * v[i].x + v[i].y * v[i].y + v[i].z * v[i].z + v[i].w * v[i].w; }
        ss = wave_sum(ss);
        const float rstd = rsqrtf(ss * (1.0f / DM) + 1e-6f);
#pragma unroll
        for (int i = 0; i < 4; ++i) {
            const float4 g = ((const float4*)P.attn_norm)[i * 64 + lane];
            u32x2 o; o.x = pack2(v[i].x * rstd * g.x, v[i].y * rstd * g.y); o.y = pack2(v[i].z * rstd * g.z, v[i].w * rstd * g.w);
            *(u32x2*)(h + (size_t)r * DM + (i * 64 + lane) * 4) = o;
        }
    }
    bf16_t* pb = (bf16_t*)(ws + OFF_PB);
    for (size_t i = (size_t)blockIdx.x * 512 + tid; i < (size_t)T_TOK * 256 / 4; i += (size_t)gridDim.x * 512) {
        const float4 v = ((const float4*)P.p)[i]; u32x2 o; o.x = pack2(v.x, v.y); o.y = pack2(v.z, v.w); ((u32x2*)pb)[i] = o;
    }
    float* rs = (float*)(ws + OFF_MISC);
    for (int i = blockIdx.x * 512 + tid; i < 2 * T_TOK; i += gridDim.x * 512) rs[i] = 0.f;
}
#define EPI_LOOP_BEGIN \
    _Pragma("unroll") for (int ai = 0; ai < 2; ++ai) _Pragma("unroll") for (int m = 0; m < 4; ++m) { const int row = u.pm * 256 + ai * 128 + wr * 64 + m * 16 + fr; \
    _Pragma("unroll") for (int bj = 0; bj < 2; ++bj) { const int col = u.pn * 256 + bj * 128 + wc * 32 + fq * 8; f32x4 v0 = acc[ai][bj][m][0], v1 = acc[ai][bj][m][1];
#define EPI_LOOP_END } }
__device__ __forceinline__ u32x4 pack8(const f32x4& a, const f32x4& b) { u32x4 w; w.x = pack2(a[0], a[1]); w.y = pack2(a[2], a[3]); w.z = pack2(b[0], b[1]); w.w = pack2(b[2], b[3]); return w; }
__device__ __forceinline__ void unpack8(const u32x4& w, f32x4& a, f32x4& b) { a[0] = bflo(w.x); a[1] = bfhi(w.x); a[2] = bflo(w.y); a[3] = bfhi(w.y); b[0] = bflo(w.z); b[1] = bfhi(w.z); b[2] = bflo(w.w); b[3] = bfhi(w.w); }

struct EpiProj {
    static constexpr bool PERM = true, AFTER_DRAIN = false;
    bf16_t* projb; float* side; bf16_t* gates; const float* bgate;
    __device__ __forceinline__ void operator()(const f32x4 (&acc)[2][2][4][2], const Unit& u, int wr, int wc, int fr, int fq) const {
        EPI_LOOP_BEGIN
            if (u.pn < 12) {
                if (col < PROJ_LD) *(u32x4*)(projb + (size_t)row * PROJ_LD + col) = pack8(v0, v1);
                else { float* sp = side + (size_t)row * SIDE_LD + (col - PROJ_LD); *(f32x4*)sp = v0; *(f32x4*)(sp + 4) = v1; }
            } else {
                const int gc = col - 3072; const f32x4 b0 = *(const f32x4*)(bgate + gc), b1 = *(const f32x4*)(bgate + gc + 4);
#pragma unroll
                for (int j = 0; j < 4; ++j) { v0[j] = sigmoidf_(v0[j] + b0[j]); v1[j] = sigmoidf_(v1[j] + b1[j]); }
                *(u32x4*)(gates + (size_t)row * 2048 + gc) = pack8(v0, v1);
            }
        EPI_LOOP_END
    }
};
template <int SECOND> struct EpiMix {
    static constexpr bool PERM = true, AFTER_DRAIN = false;
    bf16_t* merged; const bf16_t* gates;
    __device__ __forceinline__ void operator()(const f32x4 (&acc)[2][2][4][2], const Unit& u, int wr, int wc, int fr, int fq) const {
        EPI_LOOP_BEGIN
            f32x4 g0, g1; unpack8(*(const u32x4*)(gates + (size_t)row * 2048 + SECOND * 1024 + col), g0, g1);
            bf16_t* mp = merged + (size_t)row * DM + col;
            f32x4 r0 = v0 * g0, r1 = v1 * g1;
            if (SECOND) { f32x4 p0, p1; unpack8(*(const u32x4*)mp, p0, p1); r0 += p0; r1 += p1; }
            *(u32x4*)mp = pack8(r0, r1);
        EPI_LOOP_END
    }
};
struct EpiRes {
    static constexpr bool PERM = true, AFTER_DRAIN = false;
    const float* xi; float* xo; bf16_t* xb; float* rowss;
    __device__ __forceinline__ void operator()(const f32x4 (&acc)[2][2][4][2], const Unit& u, int wr, int wc, int fr, int fq) const {
        EPI_LOOP_BEGIN
            const float* ip = xi + (size_t)row * DM + col; float* op = xo + (size_t)row * DM + col;
            const f32x4 r0 = *(const f32x4*)ip + v0, r1 = *(const f32x4*)(ip + 4) + v1;
            *(f32x4*)op = r0; *(f32x4*)(op + 4) = r1;
            *(u32x4*)(xb + (size_t)row * DM + col) = pack8(r0, r1);
            float ss = r0[0] * r0[0] + r0[1] * r0[1] + r0[2] * r0[2] + r0[3] * r0[3] + r1[0] * r1[0] + r1[1] * r1[1] + r1[2] * r1[2] + r1[3] * r1[3];
            ss += __shfl_xor(ss, 16); ss += __shfl_xor(ss, 32);
            if (fq == 0) atomicAdd(rowss + row, ss);
        EPI_LOOP_END
    }
};
struct EpiFF {
    static constexpr bool PERM = true, AFTER_DRAIN = false;
    bf16_t* ff; const float* rowss;
    __device__ __forceinline__ void operator()(const f32x4 (&acc)[2][2][4][2], const Unit& u, int wr, int wc, int fr, int fq) const {
#pragma unroll
        for (int ai = 0; ai < 2; ++ai)
#pragma unroll
            for (int m = 0; m < 4; ++m) {
                const int row = u.pm * 256 + ai * 128 + wr * 64 + m * 16 + fr, col = u.pn * 128 + wc * 32 + fq * 8;
                const float rstd = rsqrtf(rowss[row] * (1.0f / DM) + 1e-6f);
                f32x4 o0, o1;
#pragma unroll
                for (int j = 0; j < 4; ++j) { o0[j] = siluf_(acc[ai][0][m][0][j] * rstd) * (acc[ai][1][m][0][j] * rstd); o1[j] = siluf_(acc[ai][0][m][1][j] * rstd) * (acc[ai][1][m][1][j] * rstd); }
                *(u32x4*)(ff + (size_t)row * DFF + col) = pack8(o0, o1);
            }
    }
};
struct EpiF32 {
    static constexpr bool PERM = true, AFTER_DRAIN = false;
    float* o;
    __device__ __forceinline__ void operator()(const f32x4 (&acc)[2][2][4][2], const Unit& u, int wr, int wc, int fr, int fq) const {
        EPI_LOOP_BEGIN
            float* op = o + (size_t)row * DM + col; *(f32x4*)op = v0; *(f32x4*)(op + 4) = v1;
        EPI_LOOP_END
    }
};
struct EpiPle {
    static constexpr bool PERM = true, AFTER_DRAIN = false;
    float* o; const float* tmp; const float* rowss;
    __device__ __forceinline__ void operator()(const f32x4 (&acc)[2][2][4][2], const Unit& u, int wr, int wc, int fr, int fq) const {
        EPI_LOOP_BEGIN
            const float rstd = rsqrtf(rowss[row] * (1.0f / DM) + 1e-6f);
            float* op = o + (size_t)row * DM + col; const float* tp = tmp + (size_t)row * DM + col;
            f32x4 x0 = *(const f32x4*)op, x1 = *(const f32x4*)(op + 4); const f32x4 t0 = *(const f32x4*)tp, t1 = *(const f32x4*)(tp + 4);
#pragma unroll
            for (int j = 0; j < 4; ++j) { x0[j] += sigmoidf_(v0[j] * rstd) * t0[j]; x1[j] += sigmoidf_(v1[j] * rstd) * t1[j]; }
            *(f32x4*)op = x0; *(f32x4*)(op + 4) = x1;
        EPI_LOOP_END
    }
};
template <class Epi> __device__ __forceinline__ void run_gemm(PG8_LAS unsigned char* lds, const bf16_t* A, const bf16_t* Bt, int N, int K, const Epi& E) {
    pg8::Gemm g{A, Bt, T_TOK, N, K}; pg8::StaticOrder S; S.init(T_TOK, N, (int)gridDim.x, (int)blockIdx.x);
    __syncthreads();
    pg8::gemm_phase<Epi, pg8::StaticOrder>(lds, g, S, E);
    __syncthreads();
}
__constant__ float c_inv_freq[8] = {1.0f, 0.19392274f, 0.03760603f, 0.0072926646f, 0.0014142136f, 0.0002742482f, 5.3182957e-05f, 1.0313385e-05f};
__device__ void phase_tokprep(const Params& P) {
    unsigned char* ws = P.ws;
    bf16_t* projb = (bf16_t*)(ws + OFF_PROJ); float* side = (float*)(ws + OFF_SIDE); float* bg = (float*)(ws + OFF_BG);
    bf16_t* qk = (bf16_t*)(ws + OFF_R1); bf16_t* vdn = (bf16_t*)((unsigned char*)P.out + 64 * MiB);
    const int tid = threadIdx.x, lane = tid & 63, wid = tid >> 6, gw = blockIdx.x * 8 + wid, nw = gridDim.x * 8;
    for (int oct = gw; oct < T_TOK / 8; oct += nw) {
        const int t0 = oct * 8, s0 = t0 & (SEQ - 1);
        for (int g = 0; g < 12; ++g) {
            const int c = g * 128 + 2 * lane;
            float w0[4], w1[4];
#pragma unroll
            for (int j = 0; j < 4; ++j) { const float2 w = *(const float2*)(P.conv_w + j * 1536 + c); w0[j] = w.x; w1[j] = w.y; }
            unsigned xin[11];
#pragma unroll
            for (int i = 0; i < 11; ++i) { const int s = s0 - 3 + i; xin[i] = (s >= 0) ? *(const unsigned*)(projb + (size_t)(t0 - 3 + i) * PROJ_LD + c) : 0u; }
#pragma unroll
            for (int i = 0; i < 8; ++i) {
                float y0 = 0.f, y1 = 0.f;
#pragma unroll
                for (int j = 0; j < 4; ++j) { y0 += w0[j] * bflo(xin[i + j]); y1 += w1[j] * bfhi(xin[i + j]); }
                y0 = siluf_(y0); y1 = siluf_(y1);
                if (g < 8) {
                    const float ss = wave_sum(y0 * y0 + y1 * y1);
                    float sc = rsqrtf(ss + 1e-6f); if (g < 4) sc *= 0.08838834764831845f;
                    y0 *= sc; y1 *= sc;
                    *(unsigned*)(qk + (size_t)(t0 + i) * 1024 + c) = pack2(y0, y1);
                } else *(unsigned*)(vdn + (size_t)(t0 + i) * 512 + (c - 1024)) = pack2(y0, y1);
            }
        }
        for (int i = 0; i < 8; ++i) {
            const int tok = t0 + i; const float pos = (float)P.pos[tok];
            float* sd = side + (size_t)tok * SIDE_LD; bf16_t* pr = projb + (size_t)tok * PROJ_LD;
            const int jf = lane & 7; const float ang = pos * c_inv_freq[jf]; const float cs = cosf(ang), sn = sinf(ang);
            if (lane < 4) {
                const float b = sd[68 + lane], a = sd[72 + lane];
                const float xa = a + P.dt_bias[lane]; const float sp = xa > 20.f ? xa : log1pf(expf(xa));
                bg[(size_t)tok * 8 + lane] = 1.0f / (1.0f + expf(-b)); bg[(size_t)tok * 8 + 4 + lane] = -expf(P.a_log[lane]) * sp;
            }
#pragma unroll
            for (int pass = 0; pass < 2; ++pass) {
                const int sub = lane & 7; bf16_t* ptr = pass == 0 ? pr + 2048 + lane * 8 : pr + 2560 + sub * 8;
                const u32x4 raw = *(const u32x4*)ptr; f32x4 a, b; unpack8(raw, a, b);
                float y[8] = {a[0], a[1], a[2], a[3], b[0], b[1], b[2], b[3]};
                float ss = 0.f;
#pragma unroll
                for (int d = 0; d < 8; ++d) ss += y[d] * y[d];
                ss += __shfl_xor(ss, 1); ss += __shfl_xor(ss, 2); ss += __shfl_xor(ss, 4);
                const float rstd = rsqrtf(ss * (1.0f / 64.0f) + 1e-6f); const float* gn = (pass == 0 ? P.q_norm : P.k_norm) + sub * 8;
#pragma unroll
                for (int d = 0; d < 8; ++d) y[d] = y[d] * rstd * gn[d];
                float o[8];
#pragma unroll
                for (int d = 0; d < 8; ++d) {
                    const float other = __shfl_xor(y[d], 1); const float c_ = __shfl(cs, d), s_ = __shfl(sn, d);
                    o[d] = sub == 0 ? y[d] * c_ - other * s_ : (sub == 1 ? y[d] * c_ + other * s_ : y[d]);
                }
                const float scl = pass == 0 ? 0.125f : 1.0f;
                f32x4 oa = {o[0] * scl, o[1] * scl, o[2] * scl, o[3] * scl}, ob = {o[4] * scl, o[5] * scl, o[6] * scl, o[7] * scl};
                if (pass == 0 || lane < 8) *(u32x4*)ptr = pack8(oa, ob);
            }
            if (lane < 40) {
                float* base = lane < 32 ? sd + 128 + (lane >> 3) * 64 : sd;
                const float x1 = base[jf], x2 = base[8 + jf];
                base[jf] = x1 * cs - x2 * sn; base[8 + jf] = x2 * cs + x1 * sn;
            } else if (lane < 44) sd[64 + lane - 40] *= 0.0625f;
        }
    }
}

__device__ void dn_naive(const Params& P, int unit, float* lw  ) {
    unsigned char* ws = P.ws; const int lane = threadIdx.x & 63;
    const bf16_t* qk = (const bf16_t*)(ws + OFF_R1); const bf16_t* vdn = (const bf16_t*)((unsigned char*)P.out + 64 * MiB); const float* bg = (const float*)(ws + OFF_BG);
    bf16_t* odn = (bf16_t*)(ws + OFF_PROJ);
    const int b = unit >> 4, h = (unit >> 2) & 3, e = (unit & 3) * 32 + (lane >> 1), hd = lane & 1;
    float S[64];
#pragma unroll
    for (int i = 0; i < 64; ++i) S[i] = 0.f;
    size_t tok = (size_t)b * SEQ;
    unsigned kk = *(const unsigned*)(qk + tok * 1024 + 512 + h * 128 + 2 * lane), qq = *(const unsigned*)(qk + tok * 1024 + h * 128 + 2 * lane);
    float vv = bf2f(vdn[tok * 512 + h * 128 + e]), beta = bg[tok * 8 + h], gg = bg[tok * 8 + 4 + h];
    for (int t = 0; t < SEQ; ++t, ++tok) {
        lw[2 * lane] = bflo(kk); lw[2 * lane + 1] = bfhi(kk); lw[128 + 2 * lane] = bflo(qq); lw[128 + 2 * lane + 1] = bfhi(qq);
        const float v = vv, be = beta, al = __expf(gg);
        if (t + 1 < SEQ) { const size_t tn = tok + 1;
            kk = *(const unsigned*)(qk + tn * 1024 + 512 + h * 128 + 2 * lane); qq = *(const unsigned*)(qk + tn * 1024 + h * 128 + 2 * lane);
            vv = bf2f(vdn[tn * 512 + h * 128 + e]); beta = bg[tn * 8 + h]; gg = bg[tn * 8 + 4 + h]; }
        asm volatile("" ::: "memory");
        const f32x4* k4p = (const f32x4*)lw + hd * 16; const f32x4* q4p = (const f32x4*)lw + 32 + hd * 16;
        float d0 = 0.f, d1 = 0.f, d2 = 0.f, d3 = 0.f;
#pragma unroll
        for (int i = 0; i < 16; ++i) { const f32x4 k4 = k4p[i]; d0 += S[4 * i] * k4[0]; d1 += S[4 * i + 1] * k4[1]; d2 += S[4 * i + 2] * k4[2]; d3 += S[4 * i + 3] * k4[3]; }
        float dot = (d0 + d1) + (d2 + d3); dot += __shfl_xor(dot, 1);
        const float vn = be * (v - al * dot);
        float o0 = 0.f, o1 = 0.f, o2 = 0.f, o3 = 0.f;
#pragma unroll
        for (int i = 0; i < 16; ++i) {
            const f32x4 k4 = k4p[i], q4 = q4p[i];
            S[4 * i] = al * S[4 * i] + k4[0] * vn; S[4 * i + 1] = al * S[4 * i + 1] + k4[1] * vn; S[4 * i + 2] = al * S[4 * i + 2] + k4[2] * vn; S[4 * i + 3] = al * S[4 * i + 3] + k4[3] * vn;
            o0 += S[4 * i] * q4[0]; o1 += S[4 * i + 1] * q4[1]; o2 += S[4 * i + 2] * q4[2]; o3 += S[4 * i + 3] * q4[3];
        }
        float o = (o0 + o1) + (o2 + o3); o += __shfl_xor(o, 1);
        if (hd == 0) odn[tok * PROJ_LD + h * 128 + e] = f2bf(o);
    }
}
__device__ __forceinline__ unsigned okey(float f) { const unsigned u = __float_as_uint(f); return (u & 0x80000000u) ? ~u : (u | 0x80000000u); }
constexpr int SA_LW = 3072;
__device__ void sa_naive_query(const Params& P, int tok, float* lw) {
    unsigned char* ws = P.ws; const int lane = threadIdx.x & 63;
    const bf16_t* projb = (const bf16_t*)(ws + OFF_PROJ); const float* side = (const float*)(ws + OFF_SIDE);
    bf16_t* ob = (bf16_t*)((unsigned char*)P.out + 32 * MiB);
    const int b = tok >> 11, pos = tok & (SEQ - 1), n = pos + 1; const size_t tb = (size_t)b * SEQ;
    float* sc = lw; float* ql = lw + 2048; float* qil = lw + 2560; int* idx = (int*)(lw + 2816);
    { const u32x4 raw = *(const u32x4*)(projb + (size_t)tok * PROJ_LD + 2048 + lane * 8); f32x4 a, c; unpack8(raw, a, c); *(f32x4*)(ql + lane * 8) = a; *(f32x4*)(ql + lane * 8 + 4) = c;
      *(f32x4*)(qil + lane * 4) = *(const f32x4*)(side + (size_t)tok * SIDE_LD + 128 + lane * 4); }
    int cnt;
    if (n <= 256) {
#pragma unroll
        for (int i = 0; i < 4; ++i) idx[i * 64 + lane] = i * 64 + lane;
        cnt = n;
    } else {
        const float w0 = side[(size_t)tok * SIDE_LD + 64], w1 = side[(size_t)tok * SIDE_LD + 65], w2 = side[(size_t)tok * SIDE_LD + 66], w3 = side[(size_t)tok * SIDE_LD + 67];
#pragma unroll 1
        for (int i = 0; i * 64 < n; ++i) {
            const int key = i * 64 + lane; const int kc = key < n ? key : pos;
            const f32x4* kr = (const f32x4*)(side + (tb + kc) * SIDE_LD);
            float s0 = 0.f, s1 = 0.f, s2 = 0.f, s3 = 0.f;
#pragma unroll 4
            for (int dq = 0; dq < 16; ++dq) {
                asm volatile("" ::: "memory");
                const f32x4 kv = kr[dq]; const f32x4 q0 = ((const f32x4*)qil)[dq], q1 = ((const f32x4*)qil)[16 + dq], q2 = ((const f32x4*)qil)[32 + dq], q3 = ((const f32x4*)qil)[48 + dq];
                s0 += kv[0] * q0[0] + kv[1] * q0[1] + kv[2] * q0[2] + kv[3] * q0[3]; s1 += kv[0] * q1[0] + kv[1] * q1[1] + kv[2] * q1[2] + kv[3] * q1[3];
                s2 += kv[0] * q2[0] + kv[1] * q2[1] + kv[2] * q2[2] + kv[3] * q2[3]; s3 += kv[0] * q3[0] + kv[1] * q3[1] + kv[2] * q3[2] + kv[3] * q3[3];
            }
            float s = fmaxf(s0, 0.f) * w0; s = fmaf(fmaxf(s1, 0.f), w1, s); s = fmaf(fmaxf(s2, 0.f), w2, s); s = fmaf(fmaxf(s3, 0.f), w3, s); s += 0.0f;
            sc[key] = s;
        }
        unsigned a[32];
#pragma unroll
        for (int i = 0; i < 32; ++i) { const int key = i * 64 + lane; a[i] = key < n ? okey(sc[key < n ? key : 0]) : 0u; }
        unsigned Tm = 0;
#pragma unroll 1
        for (int bit = 31; bit >= 0; --bit) {
            const unsigned cand = Tm | (1u << bit); int c = 0;
#pragma unroll
            for (int i = 0; i < 32; ++i) c += __popcll(__ballot(a[i] >= cand));
            if (c >= 256) Tm = cand;
        }
        int cgt = 0;
#pragma unroll
        for (int i = 0; i < 32; ++i) cgt += __popcll(__ballot(a[i] > Tm));
        int rem = 256 - cgt, base = 0; const u64 lt = (1ull << lane) - 1ull;
#pragma unroll
        for (int i = 0; i < 32; ++i) {
            const u64 eq = __ballot(a[i] == Tm); const int rk = __popcll(eq & lt);
            const bool sel = (a[i] > Tm) || (a[i] == Tm && rk < rem);
            const u64 sm = __ballot(sel);
            if (sel) idx[base + __popcll(sm & lt)] = i * 64 + lane;
            base += __popcll(sm); const int ne = __popcll(eq); rem -= ne < rem ? ne : rem;
        }
        cnt = base;
    }
    float* Pm = sc; float ls[8];
#pragma unroll
    for (int h = 0; h < 8; ++h) ls[h] = 0.f;
#pragma unroll 1
    for (int r = 0; r < 4; ++r) {
        const int kk = r * 64 + lane; const bool ok = kk < cnt; const int key = ok ? idx[kk] : 0;
        const u32x4* kr = (const u32x4*)(projb + (tb + key) * PROJ_LD + 2560);
        float lg[8];
#pragma unroll
        for (int h = 0; h < 8; ++h) lg[h] = 0.f;
        u32x4 nxt = kr[0];
#pragma unroll 1
        for (int j = 0; j < 8; ++j) {
            const u32x4 cur = nxt; if (j < 7) nxt = kr[j + 1];
            f32x4 x, y; unpack8(cur, x, y);
            const f32x4* qp = (const f32x4*)ql + 2 * j;
#pragma unroll
            for (int h = 0; h < 8; ++h) { const f32x4 qa = qp[h * 16], qb = qp[h * 16 + 1];
                lg[h] += (x[0] * qa[0] + x[1] * qa[1]) + (x[2] * qa[2] + x[3] * qa[3]) + (y[0] * qb[0] + y[1] * qb[1]) + (y[2] * qb[2] + y[3] * qb[3]); }
        }
        float pv[8];
#pragma unroll
        for (int h = 0; h < 8; ++h) { const float p = ok ? __expf(lg[h] - 8.0f) : 0.f; pv[h] = p; ls[h] += p; }
        *(f32x4*)(Pm + kk * 8) = (f32x4){pv[0], pv[1], pv[2], pv[3]}; *(f32x4*)(Pm + kk * 8 + 4) = (f32x4){pv[4], pv[5], pv[6], pv[7]};
    }
#pragma unroll
    for (int h = 0; h < 8; ++h) ls[h] = wave_sum(ls[h]);
    float o[8];
#pragma unroll
    for (int h = 0; h < 8; ++h) o[h] = 0.f;
    const bf16_t* vb = projb + tb * PROJ_LD + 2624 + lane;
#pragma unroll 1
    for (int k0 = 0; k0 < cnt; k0 += 8) {
        float vv[8];
#pragma unroll
        for (int j = 0; j < 8; ++j) { const int kk = k0 + j; const int key = idx[kk < cnt ? kk : 0]; vv[j] = kk < cnt ? bf2f(vb[(size_t)key * PROJ_LD]) : 0.f; }
#pragma unroll
        for (int j = 0; j < 8; ++j) { const f32x4 p0 = *(const f32x4*)(Pm + (k0 + j) * 8), p1 = *(const f32x4*)(Pm + (k0 + j) * 8 + 4);
            o[0] += p0[0] * vv[j]; o[1] += p0[1] * vv[j]; o[2] += p0[2] * vv[j]; o[3] += p0[3] * vv[j]; o[4] += p1[0] * vv[j]; o[5] += p1[1] * vv[j]; o[6] += p1[2] * vv[j]; o[7] += p1[3] * vv[j]; }
    }
#pragma unroll
    for (int h = 0; h < 8; ++h) ob[(size_t)tok * 512 + h * 64 + lane] = f2bf(o[h] / ls[h]);
}

__device__ void phase_gnorm(const Params& P) {
    unsigned char* ws = P.ws; const bf16_t* projb = (const bf16_t*)(ws + OFF_PROJ); bf16_t* oa = (bf16_t*)P.out;
    const int tid = threadIdx.x, lane = tid & 63, wid = tid >> 6, gw = blockIdx.x * 8 + wid, nw = gridDim.x * 8;
    f32x4 g0 = *(const f32x4*)(P.dn_norm + (lane & 15) * 8), g1 = *(const f32x4*)(P.dn_norm + (lane & 15) * 8 + 4);
    for (int tok = gw; tok < T_TOK; tok += nw) {
        f32x4 a, b, za, zb; unpack8(*(const u32x4*)(projb + (size_t)tok * PROJ_LD + lane * 8), a, b); unpack8(*(const u32x4*)(projb + (size_t)tok * PROJ_LD + 1536 + lane * 8), za, zb);
        float ss = a[0] * a[0] + a[1] * a[1] + a[2] * a[2] + a[3] * a[3] + b[0] * b[0] + b[1] * b[1] + b[2] * b[2] + b[3] * b[3];
        ss += __shfl_xor(ss, 1); ss += __shfl_xor(ss, 2); ss += __shfl_xor(ss, 4); ss += __shfl_xor(ss, 8);
        const float rstd = rsqrtf(ss * (1.0f / 128.0f) + 1e-6f);
#pragma unroll
        for (int j = 0; j < 4; ++j) { a[j] = a[j] * rstd * g0[j] * siluf_(za[j]); b[j] = b[j] * rstd * g1[j] * siluf_(zb[j]); }
        *(u32x4*)(oa + (size_t)tok * 512 + lane * 8) = pack8(a, b);
    }
}
__global__ void __launch_bounds__(512, 2) mega(Params P) {
    extern __shared__ __attribute__((aligned(16))) unsigned char shm[];
    cg::grid_group grid = cg::this_grid();
    PG8_LAS unsigned char* lds = (PG8_LAS unsigned char*)shm; float* ldsf = (float*)shm;
    unsigned char* ws = P.ws; const int wid = threadIdx.x >> 6;
    bf16_t* r1 = (bf16_t*)(ws + OFF_R1); bf16_t* projb = (bf16_t*)(ws + OFF_PROJ); float* side = (float*)(ws + OFF_SIDE); bf16_t* gates = (bf16_t*)(ws + OFF_GATES);
    float* rowss1 = (float*)(ws + OFF_MISC); float* rowss2 = rowss1 + T_TOK;
    bf16_t* oa = (bf16_t*)P.out; bf16_t* ob = (bf16_t*)((unsigned char*)P.out + 32 * MiB);
    phase_prep(P, ldsf);
    grid.sync();
    run_gemm(lds, r1, (const bf16_t*)(ws + OFF_BT1), 5120, 1024, EpiProj{projb, side, gates, P.b_gate});
    grid.sync();
    phase_tokprep(P);
    grid.sync();
    {
        float* lw = ldsf + wid * SA_LW;
        if (wid == 0) dn_naive(P, blockIdx.x, lw);
        else {
            const int slot = blockIdx.x * 7 + wid - 1;
#pragma unroll 1
            for (int tok = slot; tok < T_TOK; tok += 1792) sa_naive_query(P, tok, lw);
        }
    }
    grid.sync();
    phase_gnorm(P);
    grid.sync();
    run_gemm(lds, oa, (const bf16_t*)(ws + OFF_BTA), 1024, 512, EpiMix<0>{r1, gates});
    run_gemm(lds, ob, (const bf16_t*)(ws + OFF_BTB), 1024, 512, EpiMix<1>{r1, gates});
    grid.sync();
    run_gemm(lds, r1, (const bf16_t*)(ws + OFF_BTO), 1024, 1024, EpiRes{P.x, P.out, gates  , rowss1});
    grid.sync();
    run_gemm(lds, gates  , (const bf16_t*)(ws + OFF_BTF), 5632, 1024, EpiFF{projb  , rowss1});
    grid.sync();
    run_gemm(lds, projb  , (const bf16_t*)(ws + OFF_BTD), 1024, 2816, EpiRes{P.out, P.out, r1  , rowss2});
    run_gemm(lds, (const bf16_t*)(ws + OFF_PB), (const bf16_t*)(ws + OFF_BTP), 1024, 256, EpiF32{(float*)gates});
    grid.sync();
    run_gemm(lds, r1, (const bf16_t*)(ws + OFF_BTPG), 1024, 1024, EpiPle{P.out, (const float*)gates, rowss2});
}

extern "C" void kernel_launch(void* const* d_in, const int* in_sizes, int n_in, void* d_out, int out_size, void* d_ws, size_t ws_size, hipStream_t stream) {
    static int grid_blocks = 0;
    if (!grid_blocks) {
        int dev = 0, cus = 0, per_cu = 0;
        hipGetDevice(&dev); hipDeviceGetAttribute(&cus, hipDeviceAttributeMultiprocessorCount, dev);
        if (hipFuncSetAttribute((const void*)mega, hipFuncAttributeMaxDynamicSharedMemorySize, LDS_BYTES) != hipSuccess) fprintf(stderr, "hipFuncSetAttribute failed\n");
        hipOccupancyMaxActiveBlocksPerMultiprocessor(&per_cu, (const void*)mega, 512, LDS_BYTES);
        if (per_cu < 1) per_cu = 1;
        grid_blocks = cus * per_cu; if (grid_blocks > 256) grid_blocks = 256;
        if (ws_size < WS_END) fprintf(stderr, "workspace too small: %zu < %zu\n", ws_size, (size_t)WS_END);
    }
    Params P{};
    const float* const* f = (const float* const*)d_in;
    P.x = f[0]; P.p = f[1]; P.pos = (const int*)d_in[2]; P.attn_norm = f[3]; P.w_in = f[4]; P.conv_w = f[5]; P.a_log = f[6]; P.dt_bias = f[7]; P.dn_norm = f[8]; P.q_norm = f[9]; P.k_norm = f[10];
    P.w_ba = f[11]; P.w_bb = f[12]; P.w_gate = f[13]; P.b_gate = f[14]; P.w_o = f[15]; P.ffn_norm = f[16]; P.w_fg = f[17]; P.w_fu = f[18]; P.w_fd = f[19]; P.ple_norm = f[20]; P.w_pg = f[21]; P.w_ple = f[22];
    P.out = (float*)d_out; P.ws = (unsigned char*)d_ws;
    void* args[] = {&P};
    hipError_t e = hipLaunchCooperativeKernel((const void*)mega, dim3(grid_blocks), dim3(512), args, LDS_BYTES, stream);
    if (e != hipSuccess) fprintf(stderr, "cooperative launch failed: %s (grid %d)\n", hipGetErrorString(e), grid_blocks);
}
```

```cpp
#include <hip/hip_runtime.h>
#include <hip/hip_cooperative_groups.h>
#include <cstdio>
namespace cg = cooperative_groups;
__device__ __forceinline__ int otid() { int t = (int)threadIdx.x; asm volatile("" : "+v"(t)); return t; }
namespace pg8 {
#define PG8_LAS __attribute__((address_space(3)))
typedef unsigned short bf16_t;
typedef short bf16x8 __attribute__((ext_vector_type(8)));
typedef float f32x4 __attribute__((ext_vector_type(4)));
typedef unsigned u32x4 __attribute__((ext_vector_type(4)));
constexpr int BM = 256, BK = 64, HALF = 128, HTB = HALF * BK * 2  , STAGE_BYTES = 8 * HTB, NXCD = 8, WGM = 8;

__host__ __device__ __forceinline__ int lds_byte(int r, int c) { const int st = (r >> 4) * 2 + (c >> 5), rr = r & 15, cc = c & 31, ob = rr * 64 + cc * 2; return st * 1024 + (ob ^ (((ob >> 9) & 1) << 5)); }
__host__ __device__ __forceinline__ void stage_rc(int b, int& R, int& C) { const int st = b / 1024, sb = b % 1024, swz = sb ^ (((sb >> 9) & 1) << 5); R = (st >> 1) * 16 + swz / 64; C = (st & 1) * 32 + (swz % 64) / 2; }
__host__ __device__ __forceinline__ int perm32(int rho) { const int n = rho >> 4, i = rho & 15; return 8 * (i >> 2) + 4 * n + (i & 3); }

struct Unit { int pm, pn; };
struct Gemm { const bf16_t* A; const bf16_t* Bt; int M, N, K; const bf16_t* A2; const bf16_t* Bt2; };

struct StaticOrder {
    int nM, nN, nwg, G, c;
    __host__ __device__ void init(int M, int N, int G_, int c_) { nM = M / BM; nN = N / BM; nwg = nM * nN; G = G_; c = c_; }
    __host__ __device__ bool next(int i, Unit& u) const {
        const long L = (long)i * G + c; if (L >= nwg) return false;
        int wgid = (int)L; { const int q = nwg / NXCD, r = nwg % NXCD, xcd = wgid % NXCD, off = wgid / NXCD; wgid = (xcd < r ? xcd * (q + 1) : r * (q + 1) + (xcd - r) * q) + off; }
        const int nig = WGM * nN, gid = wgid / nig, fm = gid * WGM, gsz = (nM - fm) < WGM ? (nM - fm) : WGM;
        u.pm = fm + ((wgid % nig) % gsz); u.pn = (wgid % nig) / gsz; return true;
    }
    __device__ __forceinline__ void a_ready(const Unit&) const {}
    __device__ __forceinline__ void done(const Unit&) const {}
};
__device__ __forceinline__ unsigned cvt_pk_bf16(float lo, float hi) { unsigned r; asm volatile("v_cvt_pk_bf16_f32 %0, %1, %2" : "=v"(r) : "v"(lo), "v"(hi)); return r; }
typedef float f32x2 __attribute__((ext_vector_type(2)));
template <class Epi, class Sched>
__device__ __forceinline__ void gemm_phase(PG8_LAS unsigned char* lds, const Gemm g, const Sched& S, const Epi& E) {
    const int tid = otid(), wid = __builtin_amdgcn_readfirstlane(tid >> 6), lane = tid & 63, wr = wid >> 2, wc = wid & 3, fr = lane & 15, fq = lane >> 4;
    const int K = g.K, nt = Epi::DUAL ? 2 * (K / BK) : K / BK, nth = nt / 2;
    unsigned voffA[2], voffB[2];
#pragma unroll
    for (int i = 0; i < 2; ++i) { int R, C; stage_rc(tid * 16 + i * 8192, R, C); const int Rb = Epi::PERM ? ((R & ~31) + perm32(R & 31)) : R;
        voffA[i] = (unsigned)(R * K + C) * 2u; voffB[i] = (unsigned)(Rb * K + C) * 2u; }
    const size_t kstep = (size_t)(BK * 2);
    const size_t hstep = (size_t)HALF * K * 2;
    const size_t tstep = 2 * hstep;
    const unsigned ldsw = (unsigned)wid * 1024u;
    const int aoff = lds_byte(wr * 64 + fr, fq * 8), boff = lds_byte(wc * 32 + fr, fq * 8);
#define PG8_SA(b, h) (((b) * 2 + (h)) * HTB)
#define PG8_SB(b, h) ((4 + (b) * 2 + (h)) * HTB)
#define PG8_STAGE(bufoff, gbase, voff) do { _Pragma("unroll") for (int _i = 0; _i < 2; ++_i) \
        __builtin_amdgcn_global_load_lds((const unsigned*)((const char*)(gbase) + (voff)[_i]), (PG8_LAS unsigned*)(lds + (bufoff) + ldsw + _i * 8192), 16, 0, 0); } while (0)
#define PG8_LDA(dst, b, h) do { _Pragma("unroll") for (int m = 0; m < 4; ++m) _Pragma("unroll") for (int k = 0; k < 2; ++k) dst[m][k] = *(const PG8_LAS bf16x8*)(lds + PG8_SA(b, h) + aoff + m * 2048 + k * 1024); } while (0)
#define PG8_LDB(dst, b, h) do { _Pragma("unroll") for (int n = 0; n < 2; ++n) _Pragma("unroll") for (int k = 0; k < 2; ++k) dst[n][k] = *(const PG8_LAS bf16x8*)(lds + PG8_SB(b, h) + boff + n * 2048 + k * 1024); } while (0)
#define PG8_MMA(ai, bj, At, Bt) do { __builtin_amdgcn_s_setprio(1); _Pragma("unroll") for (int m = 0; m < 4; ++m) _Pragma("unroll") for (int n = 0; n < 2; ++n) _Pragma("unroll") for (int k = 0; k < 2; ++k) \
        acc[ai][bj][m][n] = __builtin_amdgcn_mfma_f32_16x16x32_bf16(Bt[n][k], At[m][k], acc[ai][bj][m][n], 0, 0, 0); __builtin_amdgcn_s_setprio(0); } while (0)
#define PG8_WAIT_V(n) asm volatile("s_waitcnt vmcnt(" #n ")" ::: "memory")
#define PG8_WAIT_L(n) asm volatile("s_waitcnt lgkmcnt(" #n ")" ::: "memory")
#define PG8_BAR __builtin_amdgcn_s_barrier()
#define PG8_SCHED __builtin_amdgcn_sched_barrier(0)
    Unit cur, nxt; int ui = 0;
    if (!S.next(0, cur)) return;
    f32x4 acc[2][2][4][2];
#pragma unroll
    for (int a = 0; a < 2; ++a)
#pragma unroll
        for (int b = 0; b < 2; ++b)
#pragma unroll
            for (int m = 0; m < 4; ++m)
#pragma unroll
                for (int n = 0; n < 2; ++n) acc[a][b][m][n] = (f32x4){0.f, 0.f, 0.f, 0.f};
    bf16x8 At[4][2], B0[2][2], B1[2][2];
    const char* cA = (const char*)g.A + (size_t)cur.pm * tstep; const char* cB = (const char*)g.Bt + (size_t)cur.pn * tstep;
    const char* cA2 = Epi::DUAL ? (const char*)g.A2 + (size_t)cur.pm * tstep : cA; const char* cB2 = Epi::DUAL ? (const char*)g.Bt2 + (size_t)cur.pn * tstep : cB;
#define PG8_KP(b1, b2, t) ((Epi::DUAL && (t) >= nth) ? (b2) + (size_t)((t) - nth) * kstep : (b1) + (size_t)(t) * kstep)
    S.a_ready(cur);
    PG8_STAGE(PG8_SB(0, 0), cB, voffB); PG8_STAGE(PG8_SA(0, 0), cA, voffA); PG8_STAGE(PG8_SB(0, 1), cB + hstep, voffB); PG8_STAGE(PG8_SA(0, 1), cA + hstep, voffA);
    if (wr == 1) PG8_BAR;
    PG8_WAIT_V(4); PG8_BAR;
    PG8_STAGE(PG8_SB(1, 0), cB + kstep, voffB); PG8_STAGE(PG8_SA(1, 0), cA + kstep, voffA); PG8_STAGE(PG8_SB(1, 1), cB + hstep + kstep, voffB);
    PG8_WAIT_V(6); PG8_BAR;
    for (;;) {
        const bool has_next = S.next(ui + 1, nxt);
        const char* nA = has_next ? (const char*)g.A + (size_t)nxt.pm * tstep : cA; const char* nB = has_next ? (const char*)g.Bt + (size_t)nxt.pn * tstep : cB;
        for (int t = 0; t < nt; t += 2) {
            const bool last = (t == nt - 2);
            if constexpr (Epi::DUAL) { if (t == nth) E.mid(acc, cur, wr, wc, fr, fq); }
            const char* a1 = PG8_KP(cA, cA2, t + 1);
            const char* a2 = last ? nA : PG8_KP(cA, cA2, t + 2); const char* b2 = last ? nB : PG8_KP(cB, cB2, t + 2);
            const char* a3 = a2 + kstep; const char* b3 = b2 + kstep;
            if (last && has_next) S.a_ready(nxt);
            PG8_LDB(B0, 0, 0); PG8_SCHED; PG8_LDA(At, 0, 0); PG8_STAGE(PG8_SA(1, 1), a1 + hstep, voffA);
            PG8_WAIT_L(8); PG8_BAR; PG8_WAIT_L(0); PG8_MMA(0, 0, At, B0); PG8_BAR; PG8_SCHED;
            PG8_LDB(B1, 0, 1); PG8_STAGE(PG8_SB(0, 0), b2, voffB);
            PG8_BAR; PG8_WAIT_L(0); PG8_MMA(0, 1, At, B1); PG8_BAR;
            PG8_LDA(At, 0, 1); PG8_STAGE(PG8_SA(0, 0), a2, voffA);
            PG8_BAR; PG8_WAIT_L(0); PG8_MMA(1, 0, At, B0); PG8_BAR; PG8_SCHED;
            PG8_STAGE(PG8_SB(0, 1), b2 + hstep, voffB);
            PG8_WAIT_V(6); PG8_BAR; PG8_MMA(1, 1, At, B1); PG8_BAR;
            PG8_LDB(B0, 1, 0); PG8_SCHED; PG8_LDA(At, 1, 0); PG8_STAGE(PG8_SA(0, 1), a2 + hstep, voffA);
            PG8_WAIT_L(8); PG8_BAR; PG8_WAIT_L(0); PG8_MMA(0, 0, At, B0); PG8_BAR; PG8_SCHED;
            PG8_LDB(B1, 1, 1); PG8_STAGE(PG8_SB(1, 0), b3, voffB);
            PG8_BAR; PG8_WAIT_L(0); PG8_MMA(0, 1, At, B1); PG8_BAR;
            PG8_LDA(At, 1, 1); PG8_STAGE(PG8_SA(1, 0), a3, voffA);
            PG8_BAR; PG8_WAIT_L(0); PG8_MMA(1, 0, At, B0); PG8_BAR; PG8_SCHED;
            PG8_STAGE(PG8_SB(1, 1), b3 + hstep, voffB);
            PG8_WAIT_V(6); PG8_BAR; PG8_MMA(1, 1, At, B1); PG8_BAR;
        }
        if constexpr (!Epi::AFTER_DRAIN) { E(acc, cur, wr, wc, fr, fq); S.done(cur); }
        if (!has_next) break;
#pragma unroll
        for (int a = 0; a < 2; ++a)
#pragma unroll
            for (int b = 0; b < 2; ++b)
#pragma unroll
                for (int m = 0; m < 4; ++m)
#pragma unroll
                    for (int n = 0; n < 2; ++n) acc[a][b][m][n] = (f32x4){0.f, 0.f, 0.f, 0.f};
        cur = nxt; cA = nA; cB = nB; ++ui;
        if constexpr (Epi::DUAL) { cA2 = (const char*)g.A2 + (size_t)cur.pm * tstep; cB2 = (const char*)g.Bt2 + (size_t)cur.pn * tstep; }
    }
    PG8_WAIT_V(0);
    if (wr == 0) PG8_BAR;
    PG8_BAR;
    if constexpr (Epi::AFTER_DRAIN) { E.fused(acc, cur, wr, wc, fr, fq, lds, wid, lane); S.done(cur); }
#undef PG8_SA
#undef PG8_KP
#undef PG8_SB
#undef PG8_STAGE
#undef PG8_LDA
#undef PG8_LDB
#undef PG8_MMA
#undef PG8_WAIT_V
#undef PG8_WAIT_L
#undef PG8_BAR
#undef PG8_SCHED
}
}
using pg8::bf16_t; using pg8::f32x4; using pg8::u32x4; using pg8::Unit; using pg8::cvt_pk_bf16;
typedef unsigned long long u64;
typedef unsigned u32x2 __attribute__((ext_vector_type(2)));

constexpr int T_TOK = 32768, SEQ = 2048, NB = 16, DM = 1024, DFF = 2816;
constexpr int PROJ_LD = 2688, SIDE_LD = 384;
constexpr size_t MiB = 1ull << 20;
constexpr size_t OFF_BT1 = 0, OFF_BTA = 10 * MiB, OFF_BTB = 11 * MiB, OFF_BTO = 12 * MiB, OFF_BTF = 14 * MiB, OFF_BTD = 25 * MiB, OFF_BTPG = 31 * MiB, OFF_BTP = 33 * MiB,
                 OFF_MISC = 34 * MiB, OFF_BG = 35 * MiB, OFF_R1 = 36 * MiB, OFF_PB = 100 * MiB, OFF_PROJ = 116 * MiB, OFF_SIDE = 284 * MiB, OFF_GATES = 332 * MiB, WS_END = 460 * MiB;
constexpr int SC_LD = 2064;
constexpr int LDS_MASK = 16 * SC_LD * 4, LDS_CTRL = LDS_MASK + 16384, LDS_BYTES = LDS_CTRL + 64;

struct Params {
    const float *x, *p; const int* pos;
    const float *attn_norm, *w_in, *conv_w, *a_log, *dt_bias, *dn_norm, *q_norm, *k_norm, *w_ba, *w_bb, *w_gate, *b_gate, *w_o, *ffn_norm, *w_fg, *w_fu, *w_fd, *ple_norm, *w_pg, *w_ple;
    float* out; unsigned char* ws;
};

__device__ __forceinline__ float bf2f(unsigned short b) { return __uint_as_float(((unsigned)b) << 16); }
__device__ __forceinline__ unsigned short f2bf(float f) { const __bf16 v = (__bf16)f; return __builtin_bit_cast(unsigned short, v); }
__device__ __forceinline__ float bflo(unsigned u) { return __uint_as_float(u << 16); }
__device__ __forceinline__ float bfhi(unsigned u) { return __uint_as_float(u & 0xFFFF0000u); }
typedef __bf16 hbf16x2 __attribute__((ext_vector_type(2)));
typedef float hf32x2 __attribute__((ext_vector_type(2)));
__device__ __forceinline__ unsigned pack2(float a, float b) { const hf32x2 f = {a, b}; const hbf16x2 v = __builtin_convertvector(f, hbf16x2); return __builtin_bit_cast(unsigned, v); }
__device__ __forceinline__ float sigmoidf_(float v) { return __builtin_amdgcn_rcpf(1.0f + __builtin_amdgcn_exp2f(v * -1.4426950408889634f)); }
__device__ __forceinline__ float siluf_(float v) { return v * __builtin_amdgcn_rcpf(1.0f + __builtin_amdgcn_exp2f(v * -1.4426950408889634f)); }
__device__ __forceinline__ float wave_sum(float v) {
#pragma unroll
    for (int o = 32; o >= 1; o >>= 1) v += __shfl_xor(v, o);
    return v;
}

__device__ __forceinline__ int win_map(int n) {
    if (n < 2048) return n;
    if (n < 2560) return n + 8;
    if (n < 2688) return n + 8;
    if (n < 2752) return n - 2688 + 2952;
    if (n < 2756) return n - 2752 + 3016;
    if (n < 2764) return n - 2756 + 2048;
    if (n < 2816) return -1;
    return n - 2816 + 2696;
}
struct TJob { int kind; const float* s0; const float* s1; int ld; int K; int N; const float* gain; bf16_t* dst; };
struct TLoad { float v[8]; bf16_t* tbase; int K; };
__device__ __forceinline__ void tile_load(const TJob& j, int t, int tid, TLoad& L) {
    const int nkt = j.K / 64; const int kt = t % nkt, ntl = t / nkt, n = tid & 63, kc = tid >> 6, dn = ntl * 64 + n, k0 = kt * 64 + kc * 8;
    const float* sp = j.s0; int sc = dn, ld = j.ld;
    if (j.kind == 0) { if (dn < 3072) sc = win_map(dn); else { sp = j.s1; sc = dn - 3072; ld = 2048; } }
    else if (j.kind == 2) { const int tl = dn >> 8, w = dn & 255; if (w < 128) sc = tl * 128 + w; else { sp = j.s1; sc = tl * 128 + w - 128; } }
    L.tbase = j.dst + (size_t)(ntl * 64) * j.K + kt * 64; L.K = j.K;
#pragma unroll
    for (int i = 0; i < 8; ++i) { float v = 0.f; if (sc >= 0) { v = sp[(size_t)(k0 + i) * ld + sc]; if (j.gain) v *= j.gain[k0 + i]; } L.v[i] = v; }
}
__device__ __forceinline__ void tile_stage(const TLoad& L, bf16_t* lb, int tid) {
    u32x4 w; w.x = pack2(L.v[0], L.v[1]); w.y = pack2(L.v[2], L.v[3]); w.z = pack2(L.v[4], L.v[5]); w.w = pack2(L.v[6], L.v[7]); *(u32x4*)(lb + (tid & 63) * 72 + (tid >> 6) * 8) = w;
}
__device__ __forceinline__ void tile_flush(const TLoad& L, const bf16_t* lb, int tid) {
    const int row = tid >> 3, piece = tid & 7; *(u32x4*)(L.tbase + (size_t)row * L.K + piece * 8) = *(const u32x4*)(lb + row * 72 + piece * 8);
}
__device__ __forceinline__ TJob get_job(const Params& P, int& t) {
    unsigned char* ws = P.ws;
    if (t < 1280) return TJob{0, P.w_in, P.w_gate, 3020, 1024, 5120, nullptr, (bf16_t*)(ws + OFF_BT1)}; t -= 1280;
    if (t < 128) return TJob{1, P.w_ba, nullptr, 1024, 512, 1024, nullptr, (bf16_t*)(ws + OFF_BTA)}; t -= 128;
    if (t < 128) return TJob{1, P.w_bb, nullptr, 1024, 512, 1024, nullptr, (bf16_t*)(ws + OFF_BTB)}; t -= 128;
    if (t < 256) return TJob{1, P.w_o, nullptr, 1024, 1024, 1024, nullptr, (bf16_t*)(ws + OFF_BTO)}; t -= 256;
    if (t < 1408) return TJob{2, P.w_fg, P.w_fu, 2816, 1024, 5632, P.ffn_norm, (bf16_t*)(ws + OFF_BTF)}; t -= 1408;
    if (t < 704) return TJob{1, P.w_fd, nullptr, 1024, 2816, 1024, nullptr, (bf16_t*)(ws + OFF_BTD)}; t -= 704;
    if (t < 256) return TJob{1, P.w_pg, nullptr, 1024, 1024, 1024, P.ple_norm, (bf16_t*)(ws + OFF_BTPG)}; t -= 256;
    return TJob{1, P.w_ple, nullptr, 1024, 256, 1024, nullptr, (bf16_t*)(ws + OFF_BTP)};
}
constexpr int N_TTILES = 1280 + 128 + 128 + 256 + 1408 + 704 + 256 + 64;

__device__ __forceinline__ void phase_prep(const Params& P, float* lds) {
    unsigned char* ws = P.ws;
    {
        const int tid0 = otid(), G = gridDim.x;
#pragma unroll 1
        for (int t = blockIdx.x; t < N_TTILES; t += 2 * G) {
            int ta = t, tb2 = t + G; const bool hb = tb2 < N_TTILES;
            const TJob ja = get_job(P, ta); TLoad La, Lb; tile_load(ja, ta, tid0, La);
            if (hb) { const TJob jb = get_job(P, tb2); tile_load(jb, tb2, tid0, Lb); }
            bf16_t* lbA = (bf16_t*)lds; bf16_t* lbB = lbA + 64 * 72;
            tile_stage(La, lbA, tid0); if (hb) tile_stage(Lb, lbB, tid0);
            __syncthreads();
            tile_flush(La, lbA, tid0); if (hb) tile_flush(Lb, lbB, tid0);
            __syncthreads();
        }
    }
    const int tid = otid(), lane = tid & 63, wid = tid >> 6, gw = blockIdx.x * 8 + wid, nw = gridDim.x * 8;
    bf16_t* h = (bf16_t*)(ws + OFF_R1);
#pragma unroll 1
    for (int r0 = gw; r0 < T_TOK; r0 += 2 * nw) {
        float4 v[2][4]; float ss[2];
#pragma unroll
        for (int q = 0; q < 2; ++q) { const float4* xr = (const float4*)(P.x + (size_t)(r0 + q * nw) * DM); ss[q] = 0.f;
#pragma unroll
            for (int i = 0; i < 4; ++i) { const f32x4 t_ = __builtin_nontemporal_load((const f32x4*)xr + i * 64 + lane); v[q][i] = make_float4(t_[0], t_[1], t_[2], t_[3]); ss[q] += v[q][i].x * v[q][i].x + v[q][i].y * v[q][i].y + v[q][i].z * v[q][i].z + v[q][i].w * v[q][i].w; } }
#pragma unroll
        for (int q = 0; q < 2; ++q) {
            const float rstd = rsqrtf(wave_sum(ss[q]) * (1.0f / DM) + 1e-6f);
#pragma unroll
            for (int i = 0; i < 4; ++i) {
                const float4 g = ((const float4*)P.attn_norm)[i * 64 + lane];
                u32x2 o; o.x = pack2(v[q][i].x * rstd * g.x, v[q][i].y * rstd * g.y); o.y = pack2(v[q][i].z * rstd * g.z, v[q][i].w * rstd * g.w);
                *(u32x2*)(h + (size_t)(r0 + q * nw) * DM + (i * 64 + lane) * 4) = o;
            }
        }
    }
    bf16_t* pb = (bf16_t*)(ws + OFF_PB);
    {
        const size_t nth = (size_t)gridDim.x * 512, n4 = (size_t)T_TOK * 256 / 4;
#pragma unroll 1
        for (size_t i = (size_t)blockIdx.x * 512 + tid; i < n4; i += 4 * nth) {
            float4 v[4];
#pragma unroll
            for (int q = 0; q < 4; ++q) v[q] = ((const float4*)P.p)[i + q * nth];
#pragma unroll
            for (int q = 0; q < 4; ++q) { u32x2 o; o.x = pack2(v[q].x, v[q].y); o.y = pack2(v[q].z, v[q].w); ((u32x2*)pb)[i + q * nth] = o; }
        }
    }
    float* rs = (float*)(ws + OFF_MISC);
    for (int i = blockIdx.x * 512 + tid; i < 2 * T_TOK; i += gridDim.x * 512) rs[i] = 0.f;
}
#define EPI_LOOP_BEGIN \
    _Pragma("unroll") for (int ai = 0; ai < 2; ++ai) _Pragma("unroll") for (int m = 0; m < 4; ++m) { const int row = u.pm * 256 + ai * 128 + wr * 64 + m * 16 + fr; \
    _Pragma("unroll") for (int bj = 0; bj < 2; ++bj) { const int col = u.pn * 256 + bj * 128 + wc * 32 + fq * 8; f32x4 v0 = acc[ai][bj][m][0], v1 = acc[ai][bj][m][1];
#define EPI_LOOP_END } }
__device__ __forceinline__ u32x2 pack4(const f32x4& a) { u32x2 w; w.x = pack2(a[0], a[1]); w.y = pack2(a[2], a[3]); return w; }
__device__ __forceinline__ u32x4 pack8(const f32x4& a, const f32x4& b) { u32x4 w; w.x = pack2(a[0], a[1]); w.y = pack2(a[2], a[3]); w.z = pack2(b[0], b[1]); w.w = pack2(b[2], b[3]); return w; }
__device__ __forceinline__ void unpack8(const u32x4& w, f32x4& a, f32x4& b) { a[0] = bflo(w.x); a[1] = bfhi(w.x); a[2] = bflo(w.y); a[3] = bfhi(w.y); b[0] = bflo(w.z); b[1] = bfhi(w.z); b[2] = bflo(w.w); b[3] = bfhi(w.w); }

struct EpiProj {
    static constexpr bool PERM = true, AFTER_DRAIN = false, DUAL = false;
    bf16_t* projb; float* side; bf16_t* gates; const float* bgate;
    __device__ __forceinline__ void operator()(const f32x4 (&acc)[2][2][4][2], const Unit& u, int wr, int wc, int fr, int fq) const {
        EPI_LOOP_BEGIN
            if (u.pn < 12) {
                if (col < PROJ_LD) *(u32x4*)(projb + (size_t)row * PROJ_LD + col) = pack8(v0, v1);
                else { float* sp = side + (size_t)row * SIDE_LD + (col - PROJ_LD); *(f32x4*)sp = v0; *(f32x4*)(sp + 4) = v1; }
            } else {
                const int gc = col - 3072; const f32x4 b0 = *(const f32x4*)(bgate + gc), b1 = *(const f32x4*)(bgate + gc + 4);
#pragma unroll
                for (int j = 0; j < 4; ++j) { v0[j] = sigmoidf_(v0[j] + b0[j]); v1[j] = sigmoidf_(v1[j] + b1[j]); }
                *(u32x4*)(gates + (size_t)row * 2048 + gc) = pack8(v0, v1);
            }
        EPI_LOOP_END
    }
};
struct EpiMixDual {
    static constexpr bool PERM = true, AFTER_DRAIN = false, DUAL = true;
    bf16_t* merged; const bf16_t* gates;
    __device__ __forceinline__ void mid(f32x4 (&acc)[2][2][4][2], const Unit& u, int wr, int wc, int fr, int fq) const {
#pragma unroll
        for (int ai = 0; ai < 2; ++ai)
#pragma unroll
            for (int m = 0; m < 4; ++m) { const int row = u.pm * 256 + ai * 128 + wr * 64 + m * 16 + fr;
#pragma unroll
                for (int bj = 0; bj < 2; ++bj) { const int col = u.pn * 256 + bj * 128 + wc * 32 + fq * 8;
                    f32x4 a0, a1, b0, b1; unpack8(*(const u32x4*)(gates + (size_t)row * 2048 + col), a0, a1); unpack8(*(const u32x4*)(gates + (size_t)row * 2048 + 1024 + col), b0, b1);
#pragma unroll
                    for (int j = 0; j < 4; ++j) { acc[ai][bj][m][0][j] *= a0[j] * __builtin_amdgcn_rcpf(b0[j]); acc[ai][bj][m][1][j] *= a1[j] * __builtin_amdgcn_rcpf(b1[j]); } } }
    }
    __device__ __forceinline__ void operator()(const f32x4 (&acc)[2][2][4][2], const Unit& u, int wr, int wc, int fr, int fq) const {
        EPI_LOOP_BEGIN
            f32x4 g0, g1; unpack8(*(const u32x4*)(gates + (size_t)row * 2048 + 1024 + col), g0, g1);
            *(u32x4*)(merged + (size_t)row * DM + col) = pack8(v0 * g0, v1 * g1);
        EPI_LOOP_END
    }
};
template <int FIRST> struct EpiRes {
    static constexpr bool PERM = true, AFTER_DRAIN = false, DUAL = false;
    const float* xf; const bf16_t* xbi; bf16_t* xb; float* rowss;
    __device__ __forceinline__ void operator()(const f32x4 (&acc)[2][2][4][2], const Unit& u, int wr, int wc, int fr, int fq) const {
#pragma unroll
        for (int ai = 0; ai < 2; ++ai)
#pragma unroll
            for (int m = 0; m < 4; ++m) {
                const int row = u.pm * 256 + ai * 128 + wr * 64 + m * 16 + fr; float ss = 0.f;
#pragma unroll
                for (int bj = 0; bj < 2; ++bj) {
                    const int col = u.pn * 256 + bj * 128 + wc * 32 + fq * 8; const f32x4 v0 = acc[ai][bj][m][0], v1 = acc[ai][bj][m][1];
                    f32x4 r0, r1;
                    if (FIRST) { const float* ip = xf + (size_t)row * DM + col; r0 = __builtin_nontemporal_load((const f32x4*)ip); r1 = __builtin_nontemporal_load((const f32x4*)(ip + 4)); }
                    else unpack8(*(const u32x4*)(xbi + (size_t)row * DM + col), r0, r1);
                    r0 += v0; r1 += v1;
                    *(u32x4*)(xb + (size_t)row * DM + col) = pack8(r0, r1);
                    ss += r0[0] * r0[0] + r0[1] * r0[1] + r0[2] * r0[2] + r0[3] * r0[3] + r1[0] * r1[0] + r1[1] * r1[1] + r1[2] * r1[2] + r1[3] * r1[3];
                }
                ss += __shfl_xor(ss, 16); ss += __shfl_xor(ss, 32);
                if (fq == 0) atomicAdd(rowss + row, ss);
            }
    }
};
struct EpiFF {
    static constexpr bool PERM = true, AFTER_DRAIN = false, DUAL = false;
    bf16_t* ff; const float* rowss;
    __device__ __forceinline__ void operator()(const f32x4 (&acc)[2][2][4][2], const Unit& u, int wr, int wc, int fr, int fq) const {
#pragma unroll
        for (int ai = 0; ai < 2; ++ai)
#pragma unroll
            for (int m = 0; m < 4; ++m) {
                const int row = u.pm * 256 + ai * 128 + wr * 64 + m * 16 + fr, col = u.pn * 128 + wc * 32 + fq * 8;
                const float rstd = rsqrtf(rowss[row] * (1.0f / DM) + 1e-6f);
                f32x4 o0, o1;
#pragma unroll
                for (int j = 0; j < 4; ++j) { o0[j] = siluf_(acc[ai][0][m][0][j] * rstd) * (acc[ai][1][m][0][j] * rstd); o1[j] = siluf_(acc[ai][0][m][1][j] * rstd) * (acc[ai][1][m][1][j] * rstd); }
                *(u32x4*)(ff + (size_t)row * DFF + col) = pack8(o0, o1);
            }
    }
};
struct EpiTmp {
    static constexpr bool PERM = true, AFTER_DRAIN = false, DUAL = false;
    bf16_t* o;
    __device__ __forceinline__ void operator()(const f32x4 (&acc)[2][2][4][2], const Unit& u, int wr, int wc, int fr, int fq) const {
        EPI_LOOP_BEGIN
            *(u32x4*)(o + (size_t)row * DM + col) = pack8(v0, v1);
        EPI_LOOP_END
    }
};
struct EpiPle {
    static constexpr bool PERM = true, AFTER_DRAIN = false, DUAL = false;
    float* o; const bf16_t* x2b; const bf16_t* tmp; const float* rowss;
    __device__ __forceinline__ void operator()(const f32x4 (&acc)[2][2][4][2], const Unit& u, int wr, int wc, int fr, int fq) const {
        EPI_LOOP_BEGIN
            const float rstd = rsqrtf(rowss[row] * (1.0f / DM) + 1e-6f);
            float* op = o + (size_t)row * DM + col;
            f32x4 x0, x1, t0, t1; unpack8(*(const u32x4*)(x2b + (size_t)row * DM + col), x0, x1); unpack8(*(const u32x4*)(tmp + (size_t)row * DM + col), t0, t1);
#pragma unroll
            for (int j = 0; j < 4; ++j) { x0[j] += sigmoidf_(v0[j] * rstd) * t0[j]; x1[j] += sigmoidf_(v1[j] * rstd) * t1[j]; }
            __builtin_nontemporal_store(x0, (f32x4*)op); __builtin_nontemporal_store(x1, (f32x4*)(op + 4));
        EPI_LOOP_END
    }
};
template <class Epi> __device__ __forceinline__ void run_gemm(PG8_LAS unsigned char* lds, const bf16_t* A, const bf16_t* Bt, int N, int K, const Epi& E, const bf16_t* A2 = nullptr, const bf16_t* Bt2 = nullptr) {
    pg8::Gemm g{A, Bt, T_TOK, N, K, A2, Bt2}; pg8::StaticOrder S; S.init(T_TOK, N, (int)gridDim.x, (int)blockIdx.x);
    __syncthreads();
    pg8::gemm_phase<Epi, pg8::StaticOrder>(lds, g, S, E);
    __syncthreads();
}
__constant__ float c_inv_freq[8] = {1.0f, 0.19392274f, 0.03760603f, 0.0072926646f, 0.0014142136f, 0.0002742482f, 5.3182957e-05f, 1.0313385e-05f};
#ifndef NREP_CONV
#define NREP_CONV 1
#endif
#ifndef REP
#define REP(n) _Pragma("unroll 1") for (int rep_ = 0; rep_ < (n); ++rep_)
#endif
__device__ __forceinline__ void phase_tokprep(const Params& P, unsigned char* shm) {
    unsigned char* ws = P.ws;
    bf16_t* projb = (bf16_t*)(ws + OFF_PROJ); float* side = (float*)(ws + OFF_SIDE); float* bg = (float*)(ws + OFF_BG);
    bf16_t* qk = (bf16_t*)(ws + OFF_R1); bf16_t* vT = (bf16_t*)((unsigned char*)P.out + 64 * MiB); bf16_t* kT = (bf16_t*)((unsigned char*)P.out + 96 * MiB);
    const int tid = otid(), lane = tid & 63, wid = tid >> 6, gw = blockIdx.x * 8 + wid, nw = gridDim.x * 8;
#pragma unroll 1
    for (int oct = gw; oct < T_TOK / 8; oct += nw) {
        const int t0 = oct * 8, s0 = t0 & (SEQ - 1);
        REP(NREP_CONV)
#pragma unroll 1
        for (int g3 = 0; g3 < 4; ++g3) {
            unsigned xin[3][11]; float2 wv[3][4];
#pragma unroll
            for (int q = 0; q < 3; ++q) { const int c = (g3 * 3 + q) * 128 + 2 * lane;
#pragma unroll
                for (int j = 0; j < 4; ++j) wv[q][j] = *(const float2*)(P.conv_w + j * 1536 + c);
#pragma unroll
                for (int i = 0; i < 11; ++i) { const int s = s0 - 3 + i; xin[q][i] = (s >= 0) ? *(const unsigned*)(projb + (size_t)(t0 - 3 + i) * PROJ_LD + c) : 0u; } }
#pragma unroll
            for (int q = 0; q < 3; ++q) {
                const int g = g3 * 3 + q, c = g * 128 + 2 * lane;
                unsigned short tp0[8], tp1[8];
#pragma unroll
                for (int i = 0; i < 8; ++i) {
                    float y0 = 0.f, y1 = 0.f;
#pragma unroll
                    for (int j = 0; j < 4; ++j) { y0 += wv[q][j].x * bflo(xin[q][i + j]); y1 += wv[q][j].y * bfhi(xin[q][i + j]); }
                    y0 = siluf_(y0); y1 = siluf_(y1);
                    if (g < 8) {
                        const float ss = wave_sum(y0 * y0 + y1 * y1);
                        float sc = rsqrtf(ss + 1e-6f); if (g < 4) sc *= 0.08838834764831845f;
                        y0 *= sc; y1 *= sc;
                        *(unsigned*)(qk + (size_t)(t0 + i) * 1024 + c) = pack2(y0, y1);
                    }
                    tp0[i] = f2bf(y0); tp1[i] = f2bf(y1);
                }
                if (g >= 4) {
                    u32x4 w0, w1; w0.x = tp0[0] | ((unsigned)tp0[1] << 16); w0.y = tp0[2] | ((unsigned)tp0[3] << 16); w0.z = tp0[4] | ((unsigned)tp0[5] << 16); w0.w = tp0[6] | ((unsigned)tp0[7] << 16);
                    w1.x = tp1[0] | ((unsigned)tp1[1] << 16); w1.y = tp1[2] | ((unsigned)tp1[3] << 16); w1.z = tp1[4] | ((unsigned)tp1[5] << 16); w1.w = tp1[6] | ((unsigned)tp1[7] << 16);
                    bf16_t* sp = (bf16_t*)shm + ((size_t)((g - 4) * 128 + 2 * lane) * 72 + wid * 8);
                    *(u32x4*)sp = w0; *(u32x4*)(sp + 72) = w1;
                }
            }
        }
        __syncthreads();
        {
            const int cb = t0 >> 11, cn = (t0 & (SEQ - 1)) >> 6;
#pragma unroll 4
            for (int i = 0; i < 16; ++i) {
                const int idx = i * 512 + tid, row = idx >> 3, piece = idx & 7, gg = row >> 7, ch = row & 127;
                const u32x4 v = *(const u32x4*)((const bf16_t*)shm + (size_t)row * 72 + piece * 8);
                bf16_t* dst = (gg < 4 ? kT : vT) + ((size_t)((cb * 4 + (gg & 3)) * 32 + cn) * 128 + ch) * 64 + piece * 8;
                *(u32x4*)dst = v;
            }
        }
        __syncthreads();
        const int jf = lane & 7, sub = lane & 7;
        const float dtb = P.dt_bias[lane & 3], nal = -expf(P.a_log[lane & 3]);
#pragma unroll 1
        for (int tb4 = 0; tb4 < 8; tb4 += 4) {
        int posi[4]; u32x4 rq[4], rk[4]; float sa[4], sb[4], skv[4], swv[4]; f32x4 sqv[4];
#pragma unroll
        for (int i = 0; i < 4; ++i) {
            const int tok = t0 + tb4 + i; const float* sd = side + (size_t)tok * SIDE_LD; const bf16_t* pr = projb + (size_t)tok * PROJ_LD;
            posi[i] = P.pos[tok]; rq[i] = *(const u32x4*)(pr + 2048 + lane * 8); rk[i] = *(const u32x4*)(pr + 2560 + sub * 8);
            sb[i] = sd[68 + (lane & 3)]; sa[i] = sd[72 + (lane & 3)]; skv[i] = sd[lane]; swv[i] = sd[64 + (lane & 3)]; sqv[i] = *(const f32x4*)(sd + 128 + lane * 4);
        }
#pragma unroll
        for (int i = 0; i < 4; ++i) {
            const int tok = t0 + tb4 + i; const float pos = (float)posi[i];
            float* sd = side + (size_t)tok * SIDE_LD; bf16_t* pr = projb + (size_t)tok * PROJ_LD;
            const float ang = pos * c_inv_freq[jf]; const float cs = cosf(ang), sn = sinf(ang);
            if (lane < 4) {
                const float xa = sa[i] + dtb; const float sp = xa > 20.f ? xa : log1pf(expf(xa));
                bg[(size_t)tok * 8 + lane] = 1.0f / (1.0f + expf(-sb[i])); bg[(size_t)tok * 8 + 4 + lane] = nal * sp;
            }
#pragma unroll
            for (int pass = 0; pass < 2; ++pass) {
                bf16_t* ptr = pass == 0 ? pr + 2048 + lane * 8 : pr + 2560 + sub * 8;
                const u32x4 raw = pass == 0 ? rq[i] : rk[i]; f32x4 a, b; unpack8(raw, a, b);
                float y[8] = {a[0], a[1], a[2], a[3], b[0], b[1], b[2], b[3]};
                float ss = 0.f;
#pragma unroll
                for (int d = 0; d < 8; ++d) ss += y[d] * y[d];
                ss += __shfl_xor(ss, 1); ss += __shfl_xor(ss, 2); ss += __shfl_xor(ss, 4);
                const float rstd = rsqrtf(ss * (1.0f / 64.0f) + 1e-6f); const float* gn = (pass == 0 ? P.q_norm : P.k_norm) + sub * 8;
#pragma unroll
                for (int d = 0; d < 8; ++d) y[d] = y[d] * rstd * gn[d];
                float o[8];
#pragma unroll
                for (int d = 0; d < 8; ++d) {
                    const float other = __shfl_xor(y[d], 1); const float c_ = __shfl(cs, d), s_ = __shfl(sn, d);
                    o[d] = sub == 0 ? y[d] * c_ - other * s_ : (sub == 1 ? y[d] * c_ + other * s_ : y[d]);
                }
                const float scl = pass == 0 ? 0.18033688011112042f : 1.0f;
                f32x4 oa = {o[0] * scl, o[1] * scl, o[2] * scl, o[3] * scl}, ob = {o[4] * scl, o[5] * scl, o[6] * scl, o[7] * scl};
                if (pass == 0 || lane < 8) *(u32x4*)ptr = pack8(oa, ob);
            }
            {
                const float kx_lo = __shfl(skv[i], lane & 7), kx_hi = __shfl(skv[i], 8 + (lane & 7));
                const float kr = lane < 8 ? kx_lo * cs - kx_hi * sn : (lane < 16 ? kx_hi * cs + kx_lo * sn : skv[i]);
                const float khi = bf2f(f2bf(kr)); bf16_t* kb = (bf16_t*)sd;
                const int sq = lane & 15; f32x4 qv = sqv[i]; f32x4 pv;
#pragma unroll
                for (int e = 0; e < 4; ++e) pv[e] = __shfl_xor(qv[e], 2);
#pragma unroll
                for (int e = 0; e < 4; ++e) { const int fj = (sq & 1) * 4 + e; const float c_ = __shfl(cs, fj), s_ = __shfl(sn, fj);
                    qv[e] = sq < 2 ? qv[e] * c_ - pv[e] * s_ : (sq < 4 ? qv[e] * c_ + pv[e] * s_ : qv[e]); }
                f32x4 qh; u32x2 whi = pack4(qv);
                qh[0] = bflo(whi.x); qh[1] = bfhi(whi.x); qh[2] = bflo(whi.y); qh[3] = bfhi(whi.y);
                bf16_t* qb_ = (bf16_t*)(sd + 128 + (lane >> 4) * 64);
                kb[lane] = f2bf(kr); kb[64 + lane] = f2bf(kr - khi);
                *(u32x2*)(qb_ + sq * 4) = whi; *(u32x2*)(qb_ + 64 + sq * 4) = pack4(qv - qh);
                if (lane >= 40 && lane < 44) sd[64 + (lane & 3)] = swv[i] * 0.0625f;
            }
        }
        }
    }
}

typedef short bf16x8 __attribute__((ext_vector_type(8)));
typedef short s16x4 __attribute__((ext_vector_type(4)));
#define MFMA16(a, b, c) __builtin_amdgcn_mfma_f32_16x16x32_bf16(a, b, c, 0, 0, 0)
__device__ __forceinline__ bf16x8 cat8(const s16x4 a, const s16x4 b) { return __builtin_shufflevector(a, b, 0, 1, 2, 3, 4, 5, 6, 7); }
__device__ __forceinline__ bf16x8 packf8(const f32x4& a, const f32x4& b) { const u32x4 w = pack8(a, b); return __builtin_bit_cast(bf16x8, w); }
constexpr size_t OFF_WNEG = 460 * MiB, OFF_INTRA = 492 * MiB, OFF_GCB = 508 * MiB;
__device__ __forceinline__ void dn_d1(const Params& P, int ch, float* lw  ) {
    unsigned char* ws = P.ws; const int lane = otid() & 63, lr = lane & 15, lq = lane >> 4;
    const bf16_t* qk = (const bf16_t*)(ws + OFF_R1); const float* bg = (const float*)(ws + OFF_BG);
    const bf16_t* vT = (const bf16_t*)((unsigned char*)P.out + 64 * MiB); const bf16_t* kT = (const bf16_t*)((unsigned char*)P.out + 96 * MiB);
    bf16_t* uT = (bf16_t*)P.out; bf16_t* wneg = (bf16_t*)(ws + OFF_WNEG); bf16_t* intra = (bf16_t*)(ws + OFF_INTRA); float* gcb = (float*)(ws + OFF_GCB);
    const int b = ch >> 7, h = (ch >> 5) & 3, n = ch & 31; const size_t tok0 = (size_t)b * SEQ + n * 64;
    const float beta = bg[(tok0 + lane) * 8 + h];
    float gc = bg[(tok0 + lane) * 8 + 4 + h];
#pragma unroll
    for (int o = 1; o < 64; o <<= 1) { const float t = __shfl_up(gc, o); if (lane >= o) gc += t; }
    const float glast = __shfl(gc, 63), egc = __expf(gc);
    gcb[(size_t)ch * 192 + lane] = egc; gcb[(size_t)ch * 192 + 64 + lane] = __expf(glast - gc); if (lane == 0) gcb[(size_t)ch * 192 + 128] = __expf(glast);
    bf16x8 kf[4][4], qf[4][4];
#pragma unroll
    for (int t = 0; t < 4; ++t)
#pragma unroll
        for (int ks = 0; ks < 4; ++ks) { const bf16_t* rp = qk + (tok0 + t * 16 + lr) * 1024 + h * 128 + ks * 32 + lq * 8; qf[t][ks] = *(const bf16x8*)rp; kf[t][ks] = *(const bf16x8*)(rp + 512); }
#pragma unroll
    for (int mt = 0; mt < 4; ++mt)
#pragma unroll
        for (int nt = 0; nt <= mt; ++nt) {
            f32x4 acc = {0.f, 0.f, 0.f, 0.f};
#pragma unroll
            for (int ks = 0; ks < 4; ++ks) acc = MFMA16(kf[mt][ks], kf[nt][ks], acc);
            const int e = nt * 16 + lr; const float gce = __shfl(gc, e);
#pragma unroll
            for (int j = 0; j < 4; ++j) { const int c = mt * 16 + lq * 4 + j; const float gcc = __shfl(gc, c), bc = __shfl(beta, c);
                lw[c * 64 + e] = (e < c) ? bc * acc[j] * __expf(gcc - gce) : 0.f; }
        }
#pragma unroll
    for (int et = 0; et < 4; ++et)
#pragma unroll
        for (int ct = 0; ct < 4; ++ct) {
            f32x4 val = {0.f, 0.f, 0.f, 0.f};
            if (et <= ct) {
                f32x4 acc = {0.f, 0.f, 0.f, 0.f};
#pragma unroll
                for (int ks = 0; ks < 4; ++ks) acc = MFMA16(kf[et][ks], qf[ct][ks], acc);
                const int c = ct * 16 + lr; const float gcc = __shfl(gc, c);
#pragma unroll
                for (int j = 0; j < 4; ++j) { const int e = et * 16 + lq * 4 + j; const float gce = __shfl(gc, e); val[j] = (e <= c) ? acc[j] * __expf(gcc - gce) : 0.f; }
            }
            *(u32x2*)(intra + ((size_t)ch * 64 + ct * 16 + lr) * 64 + et * 16 + lq * 4) = pack4(val);
        }
    float Tr[64];
    Tr[0] = lane == 0 ? 1.f : 0.f;
#pragma unroll
    for (int c = 1; c < 64; ++c) {
        __builtin_amdgcn_sched_barrier(0);
        int off = c * 64, lo = lane; asm volatile("" : "+v"(off), "+v"(lo) : "v"(Tr[c - 1]));
        float a0 = 0.f, a1 = 0.f;
#pragma unroll
        for (int e4 = 0; e4 * 4 < c; ++e4) {
            const f32x4 l = *(const f32x4*)(lw + off + e4 * 4);
            if (e4 * 4 + 0 < c) a0 += l[0] * Tr[e4 * 4 + 0];
            if (e4 * 4 + 1 < c) a1 += l[1] * Tr[e4 * 4 + 1];
            if (e4 * 4 + 2 < c) a0 += l[2] * Tr[e4 * 4 + 2];
            if (e4 * 4 + 3 < c) a1 += l[3] * Tr[e4 * 4 + 3];
        }
        Tr[c] = (lo == c ? 1.f : 0.f) - (a0 + a1);
    }
    __builtin_amdgcn_sched_barrier(0);
    bf16_t* Tu = (bf16_t*)lw; bf16_t* Tw = Tu + 4096;
    {
        int off = lane; asm volatile("" : "+v"(off) : "v"(Tr[63]));
        const float bw = beta * egc;
#pragma unroll
        for (int c = 0; c < 64; ++c) { Tu[c * 64 + off] = f2bf(Tr[c] * beta); Tw[c * 64 + off] = f2bf(Tr[c] * bw); }
    }
    __builtin_amdgcn_sched_barrier(0);
#pragma unroll
    for (int mt = 0; mt < 4; ++mt) {
        const bf16x8 a0 = *(const bf16x8*)(Tu + (mt * 16 + lr) * 64 + lq * 8), a1 = *(const bf16x8*)(Tu + (mt * 16 + lr) * 64 + 32 + lq * 8);
#pragma unroll
        for (int nt = 0; nt < 8; ++nt) {
            const bf16_t* vp = vT + ((size_t)ch * 128 + nt * 16 + lr) * 64 + lq * 8;
            f32x4 acc = {0.f, 0.f, 0.f, 0.f};
            acc = MFMA16(a0, *(const bf16x8*)vp, acc); acc = MFMA16(a1, *(const bf16x8*)(vp + 32), acc);
            *(u32x2*)(uT + ((size_t)ch * 128 + nt * 16 + lr) * 64 + mt * 16 + lq * 4) = pack4(acc);
        }
    }
#pragma unroll
    for (int nt = 0; nt < 8; ++nt) {
        const bf16_t* kp = kT + ((size_t)ch * 128 + nt * 16 + lr) * 64 + lq * 8;
        const bf16x8 k0 = *(const bf16x8*)kp, k1 = *(const bf16x8*)(kp + 32);
#pragma unroll
        for (int ct = 0; ct < 4; ++ct) {
            const bf16x8 b0 = *(const bf16x8*)(Tw + (ct * 16 + lr) * 64 + lq * 8), b1 = *(const bf16x8*)(Tw + (ct * 16 + lr) * 64 + 32 + lq * 8);
            f32x4 acc = {0.f, 0.f, 0.f, 0.f};
            acc = MFMA16(k0, b0, acc); acc = MFMA16(k1, b1, acc);
            *(u32x2*)(wneg + ((size_t)ch * 64 + ct * 16 + lr) * 128 + nt * 16 + lq * 4) = pack4(-acc);
        }
    }
}
#define LDS_BARRIER() do { asm volatile("s_waitcnt lgkmcnt(0)" ::: "memory"); __builtin_amdgcn_s_barrier(); asm volatile("" ::: "memory"); } while (0)
struct D2Ops { bf16x8 w[4], q[4], in[2], kt[2][2]; u32x2 u[2]; f32x4 egc, dec; float egl; };
__device__ __forceinline__ void d2_load(D2Ops& o, const bf16_t* qk, const bf16_t* kT, const bf16_t* uT, const bf16_t* wneg, const bf16_t* intra, const float* gcb, int b, int h, int dv0, int n, int j, int lr, int lq) {
    const int ch = (b * 4 + h) * 32 + n; const size_t tok0 = (size_t)b * SEQ + n * 64; const float* gp = gcb + (size_t)ch * 192;
    const int kk = j >> 1, d = j & 1, trow = 32 * kk + (lr >> 2) * 8 + d * 4 + (lr & 3), tcol = 32 * kk + lq * 8 + d * 4;
    o.egl = gp[128]; o.egc = *(const f32x4*)(gp + tcol); o.dec = *(const f32x4*)(gp + 64 + tcol);
#pragma unroll
    for (int sl = 0; sl < 2; ++sl) o.u[sl] = *(const u32x2*)(uT + ((size_t)ch * 128 + dv0 + sl * 16 + lr) * 64 + tcol);
    const bf16_t* wp = wneg + ((size_t)ch * 64 + trow) * 128 + lq * 8; const bf16_t* qp = qk + (tok0 + trow) * 1024 + h * 128 + lq * 8;
#pragma unroll
    for (int ks = 0; ks < 4; ++ks) { o.w[ks] = *(const bf16x8*)(wp + ks * 32); o.q[ks] = *(const bf16x8*)(qp + ks * 32); }
    const bf16_t* ip = intra + ((size_t)ch * 64 + trow) * 64 + lq * 8;
#pragma unroll
    for (int k2 = 0; k2 < 2; ++k2) o.in[k2] = *(const bf16x8*)(ip + k2 * 32);
#pragma unroll
    for (int dd = 0; dd < 2; ++dd) { const int dkr = 32 * j + (lr >> 2) * 8 + dd * 4 + (lr & 3); const bf16_t* kp = kT + ((size_t)ch * 128 + dkr) * 64 + lq * 8;
#pragma unroll
        for (int k2 = 0; k2 < 2; ++k2) o.kt[dd][k2] = *(const bf16x8*)(kp + k2 * 32); }
}
__device__ __forceinline__ void dn_d2(const Params& P, unsigned char* shm) {
    unsigned char* ws = P.ws; const int tid = otid(), lane = tid & 63, wid = tid >> 6, lr = lane & 15, lq = lane >> 4, j = wid & 3, ul = wid >> 2;
    const bf16_t* qk = (const bf16_t*)(ws + OFF_R1); const bf16_t* kT = (const bf16_t*)((unsigned char*)P.out + 96 * MiB);
    const bf16_t* uT = (const bf16_t*)P.out; const bf16_t* wneg = (const bf16_t*)(ws + OFF_WNEG); const bf16_t* intra = (const bf16_t*)(ws + OFF_INTRA); const float* gcb = (const float*)(ws + OFF_GCB);
    bf16_t* odn = (bf16_t*)(ws + OFF_PROJ);
    const int xcd = blockIdx.x & 7, tq = blockIdx.x >> 3, grp = (tq >> 1) * 8 + xcd;
    const int b = grp >> 2, h = grp & 3, dv0 = ((tq & 1) * 2 + ul) * 32;
    unsigned char* ub = shm + ul * 24576; unsigned char* sbp = ub; unsigned char* vbp = ub + 16384; unsigned char* vdp = ub + 20480;
    f32x4 S0[2], S1[2];
#pragma unroll
    for (int sl = 0; sl < 2; ++sl) { S0[sl] = (f32x4){0.f, 0.f, 0.f, 0.f}; S1[sl] = (f32x4){0.f, 0.f, 0.f, 0.f}; *(u32x4*)(sbp + (size_t)(((0 * 4 + j) * 2 + sl) * 64 + lane) * 16) = (u32x4){0u, 0u, 0u, 0u}; }
    auto step = [&](const D2Ops& cur, int n) {
        const int buf = n & 1; const size_t tok0 = (size_t)b * SEQ + n * 64; const int kk = j >> 1, d = j & 1;
        LDS_BARRIER();
        bf16x8 Sb[4][2];
#pragma unroll
        for (int ks = 0; ks < 4; ++ks)
#pragma unroll
            for (int sl = 0; sl < 2; ++sl) Sb[ks][sl] = *(const bf16x8*)(sbp + (size_t)(((buf * 4 + ks) * 2 + sl) * 64 + lane) * 16);
#pragma unroll
        for (int sl = 0; sl < 2; ++sl) {
            f32x4 vn = {bflo(cur.u[sl].x), bfhi(cur.u[sl].x), bflo(cur.u[sl].y), bfhi(cur.u[sl].y)};
#pragma unroll
            for (int ks = 0; ks < 4; ++ks) vn = MFMA16(cur.w[ks], Sb[ks][sl], vn);
            *(u32x2*)(vbp + (size_t)((kk * 2 + sl) * 64 + lane) * 16 + d * 8) = pack4(vn);
            *(u32x2*)(vdp + (size_t)((kk * 2 + sl) * 64 + lane) * 16 + d * 8) = pack4(vn * cur.dec);
        }
        LDS_BARRIER();
#pragma unroll
        for (int sl = 0; sl < 2; ++sl) {
            bf16x8 Vb[2], Vd[2];
#pragma unroll
            for (int k2 = 0; k2 < 2; ++k2) { Vb[k2] = *(const bf16x8*)(vbp + (size_t)((k2 * 2 + sl) * 64 + lane) * 16); Vd[k2] = *(const bf16x8*)(vdp + (size_t)((k2 * 2 + sl) * 64 + lane) * 16); }
            f32x4 acc = {0.f, 0.f, 0.f, 0.f};
#pragma unroll
            for (int ks = 0; ks < 4; ++ks) acc = MFMA16(cur.q[ks], Sb[ks][sl], acc);
            acc *= cur.egc;
#pragma unroll
            for (int k2 = 0; k2 < 2; ++k2) acc = MFMA16(cur.in[k2], Vb[k2], acc);
#pragma unroll
            for (int jj = 0; jj < 4; ++jj) odn[(tok0 + 32 * kk + lq * 8 + d * 4 + jj) * PROJ_LD + h * 128 + dv0 + sl * 16 + lr] = f2bf(acc[jj]);
            S0[sl] *= cur.egl; S1[sl] *= cur.egl;
#pragma unroll
            for (int k2 = 0; k2 < 2; ++k2) { S0[sl] = MFMA16(cur.kt[0][k2], Vd[k2], S0[sl]); S1[sl] = MFMA16(cur.kt[1][k2], Vd[k2], S1[sl]); }
            *(u32x4*)(sbp + (size_t)((((buf ^ 1) * 4 + j) * 2 + sl) * 64 + lane) * 16) = pack8(S0[sl], S1[sl]);
        }
    };
    D2Ops A, B; d2_load(A, qk, kT, uT, wneg, intra, gcb, b, h, dv0, 0, j, lr, lq);
#pragma unroll 1
    for (int n = 0; n < 32; n += 2) {
        d2_load(B, qk, kT, uT, wneg, intra, gcb, b, h, dv0, n + 1, j, lr, lq);
        step(A, n);
        d2_load(A, qk, kT, uT, wneg, intra, gcb, b, h, dv0, n + 2 < 32 ? n + 2 : 31, j, lr, lq);
        step(B, n + 1);
    }
    __syncthreads();
}
__device__ __forceinline__ unsigned okey(float f) { const unsigned u = __float_as_uint(f); return (u & 0x80000000u) ? ~u : (u | 0x80000000u); }
constexpr int SA_LW = 3072;
__device__ void sa_naive_query(const Params& P, int tok, float* lw) {
    unsigned char* ws = P.ws; const int lane = otid() & 63;
    const bf16_t* projb = (const bf16_t*)(ws + OFF_PROJ); const float* side = (const float*)(ws + OFF_SIDE);
    bf16_t* ob = (bf16_t*)((unsigned char*)P.out + 32 * MiB);
    const int b = tok >> 11, pos = tok & (SEQ - 1), n = pos + 1; const size_t tb = (size_t)b * SEQ;
    float* sc = lw; float* ql = lw + 2048; float* qil = lw + 2560; int* idx = (int*)(lw + 2816);
    { const u32x4 raw = *(const u32x4*)(projb + (size_t)tok * PROJ_LD + 2048 + lane * 8); f32x4 a, c; unpack8(raw, a, c); *(f32x4*)(ql + lane * 8) = a; *(f32x4*)(ql + lane * 8 + 4) = c;
      *(f32x4*)(qil + lane * 4) = *(const f32x4*)(side + (size_t)tok * SIDE_LD + 128 + lane * 4); }
    int cnt;
    if (n <= 256) {
#pragma unroll
        for (int i = 0; i < 4; ++i) idx[i * 64 + lane] = i * 64 + lane;
        cnt = n;
    } else {
        const float w0 = side[(size_t)tok * SIDE_LD + 64], w1 = side[(size_t)tok * SIDE_LD + 65], w2 = side[(size_t)tok * SIDE_LD + 66], w3 = side[(size_t)tok * SIDE_LD + 67];
#pragma unroll 1
        for (int i = 0; i * 64 < n; ++i) {
            const int key = i * 64 + lane; const int kc = key < n ? key : pos;
            const f32x4* kr = (const f32x4*)(side + (tb + kc) * SIDE_LD);
            float s0 = 0.f, s1 = 0.f, s2 = 0.f, s3 = 0.f;
#pragma unroll 4
            for (int dq = 0; dq < 16; ++dq) {
                asm volatile("" ::: "memory");
                const f32x4 kv = kr[dq]; const f32x4 q0 = ((const f32x4*)qil)[dq], q1 = ((const f32x4*)qil)[16 + dq], q2 = ((const f32x4*)qil)[32 + dq], q3 = ((const f32x4*)qil)[48 + dq];
                s0 += kv[0] * q0[0] + kv[1] * q0[1] + kv[2] * q0[2] + kv[3] * q0[3]; s1 += kv[0] * q1[0] + kv[1] * q1[1] + kv[2] * q1[2] + kv[3] * q1[3];
                s2 += kv[0] * q2[0] + kv[1] * q2[1] + kv[2] * q2[2] + kv[3] * q2[3]; s3 += kv[0] * q3[0] + kv[1] * q3[1] + kv[2] * q3[2] + kv[3] * q3[3];
            }
            float s = fmaxf(s0, 0.f) * w0; s = fmaf(fmaxf(s1, 0.f), w1, s); s = fmaf(fmaxf(s2, 0.f), w2, s); s = fmaf(fmaxf(s3, 0.f), w3, s); s += 0.0f;
            sc[key] = s;
        }
        unsigned a[32];
#pragma unroll
        for (int i = 0; i < 32; ++i) { const int key = i * 64 + lane; a[i] = key < n ? okey(sc[key < n ? key : 0]) : 0u; }
        unsigned Tm = 0;
#pragma unroll 1
        for (int bit = 31; bit >= 0; --bit) {
            const unsigned cand = Tm | (1u << bit); int c = 0;
#pragma unroll
            for (int i = 0; i < 32; ++i) c += __popcll(__ballot(a[i] >= cand));
            if (c >= 256) Tm = cand;
        }
        int cgt = 0;
#pragma unroll
        for (int i = 0; i < 32; ++i) cgt += __popcll(__ballot(a[i] > Tm));
        int rem = 256 - cgt, base = 0; const u64 lt = (1ull << lane) - 1ull;
#pragma unroll
        for (int i = 0; i < 32; ++i) {
            const u64 eq = __ballot(a[i] == Tm); const int rk = __popcll(eq & lt);
            const bool sel = (a[i] > Tm) || (a[i] == Tm && rk < rem);
            const u64 sm = __ballot(sel);
            if (sel) idx[base + __popcll(sm & lt)] = i * 64 + lane;
            base += __popcll(sm); const int ne = __popcll(eq); rem -= ne < rem ? ne : rem;
        }
        cnt = base;
    }
    float* Pm = sc; float ls[8];
#pragma unroll
    for (int h = 0; h < 8; ++h) ls[h] = 0.f;
#pragma unroll 1
    for (int r = 0; r < 4; ++r) {
        const int kk = r * 64 + lane; const bool ok = kk < cnt; const int key = ok ? idx[kk] : 0;
        const u32x4* kr = (const u32x4*)(projb + (tb + key) * PROJ_LD + 2560);
        float lg[8];
#pragma unroll
        for (int h = 0; h < 8; ++h) lg[h] = 0.f;
        u32x4 nxt = kr[0];
#pragma unroll 1
        for (int j = 0; j < 8; ++j) {
            const u32x4 cur = nxt; if (j < 7) nxt = kr[j + 1];
            f32x4 x, y; unpack8(cur, x, y);
            const f32x4* qp = (const f32x4*)ql + 2 * j;
#pragma unroll
            for (int h = 0; h < 8; ++h) { const f32x4 qa = qp[h * 16], qb = qp[h * 16 + 1];
                lg[h] += (x[0] * qa[0] + x[1] * qa[1]) + (x[2] * qa[2] + x[3] * qa[3]) + (y[0] * qb[0] + y[1] * qb[1]) + (y[2] * qb[2] + y[3] * qb[3]); }
        }
        float pv[8];
#pragma unroll
        for (int h = 0; h < 8; ++h) { const float p = ok ? __expf(lg[h] - 8.0f) : 0.f; pv[h] = p; ls[h] += p; }
        *(f32x4*)(Pm + kk * 8) = (f32x4){pv[0], pv[1], pv[2], pv[3]}; *(f32x4*)(Pm + kk * 8 + 4) = (f32x4){pv[4], pv[5], pv[6], pv[7]};
    }
#pragma unroll
    for (int h = 0; h < 8; ++h) ls[h] = wave_sum(ls[h]);
    float o[8];
#pragma unroll
    for (int h = 0; h < 8; ++h) o[h] = 0.f;
    const bf16_t* vb = projb + tb * PROJ_LD + 2624 + lane;
#pragma unroll 1
    for (int k0 = 0; k0 < cnt; k0 += 8) {
        float vv[8];
#pragma unroll
        for (int j = 0; j < 8; ++j) { const int kk = k0 + j; const int key = idx[kk < cnt ? kk : 0]; vv[j] = kk < cnt ? bf2f(vb[(size_t)key * PROJ_LD]) : 0.f; }
#pragma unroll
        for (int j = 0; j < 8; ++j) { const f32x4 p0 = *(const f32x4*)(Pm + (k0 + j) * 8), p1 = *(const f32x4*)(Pm + (k0 + j) * 8 + 4);
            o[0] += p0[0] * vv[j]; o[1] += p0[1] * vv[j]; o[2] += p0[2] * vv[j]; o[3] += p0[3] * vv[j]; o[4] += p1[0] * vv[j]; o[5] += p1[1] * vv[j]; o[6] += p1[2] * vv[j]; o[7] += p1[3] * vv[j]; }
    }
#pragma unroll
    for (int h = 0; h < 8; ++h) ob[(size_t)tok * 512 + h * 64 + lane] = f2bf(o[h] / ls[h]);
}

__device__ __forceinline__ void phase_gnorm(const Params& P, int item) {
    unsigned char* ws = P.ws; const bf16_t* projb = (const bf16_t*)(ws + OFF_PROJ); bf16_t* oa = (bf16_t*)P.out;
    const int tid = otid(), lane = tid & 63, wid = tid >> 6;
    f32x4 g0 = *(const f32x4*)(P.dn_norm + (lane & 15) * 8), g1 = *(const f32x4*)(P.dn_norm + (lane & 15) * 8 + 4);
#pragma unroll 4
    for (int i = 0; i < 16; ++i) {
        const int tok = item * 128 + wid * 16 + i;
        f32x4 a, b, za, zb; unpack8(*(const u32x4*)(projb + (size_t)tok * PROJ_LD + lane * 8), a, b); unpack8(*(const u32x4*)(projb + (size_t)tok * PROJ_LD + 1536 + lane * 8), za, zb);
        float ss = a[0] * a[0] + a[1] * a[1] + a[2] * a[2] + a[3] * a[3] + b[0] * b[0] + b[1] * b[1] + b[2] * b[2] + b[3] * b[3];
        ss += __shfl_xor(ss, 1); ss += __shfl_xor(ss, 2); ss += __shfl_xor(ss, 4); ss += __shfl_xor(ss, 8);
        const float rstd = rsqrtf(ss * (1.0f / 128.0f) + 1e-6f);
#pragma unroll
        for (int j = 0; j < 4; ++j) { a[j] = a[j] * rstd * g0[j] * siluf_(za[j]); b[j] = b[j] * rstd * g1[j] * siluf_(zb[j]); }
        *(u32x4*)(oa + (size_t)tok * 512 + lane * 8) = pack8(a, b);
    }
}
__device__ __forceinline__ void split8(const f32x4& a, const f32x4& b, bf16x8& hi, bf16x8& lo) {
    const u32x4 w = pack8(a, b); f32x4 ha, hb; unpack8(w, ha, hb); hi = __builtin_bit_cast(bf16x8, w); lo = packf8(a - ha, b - hb);
}
#ifndef NREP_E1S
#define NREP_E1S 1
#endif
#ifndef NREP_SEL
#define NREP_SEL 1
#endif
#ifndef NREP_E2
#define NREP_E2 1
#endif
#ifndef REP
#define REP(n) _Pragma("unroll 1") for (int rep_ = 0; rep_ < (n); ++rep_)
#endif
template <int R> __device__ __forceinline__ void sa_select(const float* srow, int n, u64* mrow, int lane) {
    unsigned a[R];
#pragma unroll
    for (int i = 0; i < R; ++i) { const int key = i * 64 + lane; a[i] = key < n ? okey(srow[key < n ? key : 0]) : 0u; }
    unsigned Tm = 0; bool exact = false;
#pragma unroll 1
    for (int bit = 31; bit >= 0; --bit) {
        const unsigned cand = Tm | (1u << bit); int c = 0;
#pragma unroll
        for (int i = 0; i < R; ++i) c += __popcll(__ballot(a[i] >= cand));
        if (c >= 256) Tm = cand;
        if (c == 256) { exact = true; break; }
    }
    int rem = 1 << 30;
    if (!exact) {
        int cgt = 0;
#pragma unroll
        for (int i = 0; i < R; ++i) cgt += __popcll(__ballot(a[i] > Tm));
        rem = 256 - cgt;
    }
    const u64 lt = (1ull << lane) - 1ull;
#pragma unroll
    for (int i = 0; i < R; ++i) {
        const u64 eq = __ballot(a[i] == Tm); const int rk = __popcll(eq & lt);
        const bool sel = (a[i] > Tm) || (a[i] == Tm && rk < rem);
        const u64 sm = __ballot(sel);
        if (lane == 0) mrow[i * 64] = sm;
        const int ne = __popcll(eq); rem -= ne < rem ? ne : rem;
    }
    if (lane == 0) { for (int i = R; i < 32; ++i) mrow[i * 64] = 0ull; }
}
constexpr int KV_LD = 72;
__device__ __forceinline__ void sa_block(const Params& P, int b, int qb, unsigned char* shm) {
    unsigned char* ws = P.ws; const int tid = otid(), lane = tid & 63, wid = tid >> 6, lr = lane & 15, lq = lane >> 4;
    const bf16_t* projb = (const bf16_t*)(ws + OFF_PROJ); const float* side = (const float*)(ws + OFF_SIDE);
    bf16_t* ob = (bf16_t*)((unsigned char*)P.out + 32 * MiB);
    float* Sc = (float*)shm; u64* Mk = (u64*)(shm + LDS_MASK);
    const size_t tb = (size_t)b * SEQ; const int pos_blk = qb * 64;
#pragma unroll 1
    for (int sub = 0; sub < 4; ++sub) {
        const int pos0 = pos_blk + sub * 16; const size_t q0 = tb + pos0; const int ntile = pos0 / 16 + 1;
        REP(NREP_E1S) if (pos0 + 16 > 256) {
            bf16x8 Ah[4][2], Al[4][2]; f32x4 wq[4];
#pragma unroll
            for (int mt = 0; mt < 4; ++mt) {
                wq[mt] = *(const f32x4*)(side + (q0 + mt * 4 + lq) * SIDE_LD + 64);
#pragma unroll
                for (int ks = 0; ks < 2; ++ks) { const bf16_t* p = (const bf16_t*)(side + (q0 + mt * 4 + (lr >> 2)) * SIDE_LD + 128 + (lr & 3) * 64) + ks * 32 + lq * 8; Ah[mt][ks] = *(const bf16x8*)p; Al[mt][ks] = *(const bf16x8*)(p + 64); }
            }
            auto ldk = [&](int kt, f32x4 (&r)[4]) { const f32x4* kp = (const f32x4*)((const bf16_t*)(side + (tb + kt * 16 + lr) * SIDE_LD) + lq * 8); r[0] = kp[0]; r[1] = kp[4]; r[2] = kp[8]; r[3] = kp[12]; };
            auto score_tile = [&](int kt, const f32x4 (&r)[4]) {
                const bf16x8 Bh[2] = {__builtin_bit_cast(bf16x8, r[0]), __builtin_bit_cast(bf16x8, r[1])}, Bl[2] = {__builtin_bit_cast(bf16x8, r[2]), __builtin_bit_cast(bf16x8, r[3])};
                const int key = kt * 16 + lr;
#pragma unroll
                for (int mt = 0; mt < 4; ++mt) {
                    f32x4 acc = {0.f, 0.f, 0.f, 0.f};
#pragma unroll
                    for (int ks = 0; ks < 2; ++ks) { acc = MFMA16(Al[mt][ks], Bh[ks], acc); acc = MFMA16(Ah[mt][ks], Bl[ks], acc); }
#pragma unroll
                    for (int ks = 0; ks < 2; ++ks) acc = MFMA16(Ah[mt][ks], Bh[ks], acc);
                    float s = fmaxf(acc[0], 0.f) * wq[mt][0]; s = fmaf(fmaxf(acc[1], 0.f), wq[mt][1], s); s = fmaf(fmaxf(acc[2], 0.f), wq[mt][2], s); s = fmaf(fmaxf(acc[3], 0.f), wq[mt][3], s); s += 0.0f;
                    Sc[(mt * 4 + lq) * SC_LD + key] = s;
                }
            };
            f32x4 r0[4], r1[4], r2[4], r3[4], r4[4], r5[4];
            if (wid < ntile) ldk(wid, r0); if (wid + 8 < ntile) ldk(wid + 8, r1);
            if (wid + 16 < ntile) ldk(wid + 16, r2); if (wid + 24 < ntile) ldk(wid + 24, r3);
#pragma unroll 1
            for (int kt = wid; kt < ntile; kt += 48) {
                if (kt + 32 < ntile) ldk(kt + 32, r4); if (kt + 40 < ntile) ldk(kt + 40, r5);
                score_tile(kt, r0); if (kt + 8 < ntile) score_tile(kt + 8, r1);
                if (kt + 48 < ntile) ldk(kt + 48, r0); if (kt + 56 < ntile) ldk(kt + 56, r1);
                if (kt + 16 < ntile) score_tile(kt + 16, r2); if (kt + 24 < ntile) score_tile(kt + 24, r3);
                if (kt + 64 < ntile) ldk(kt + 64, r2); if (kt + 72 < ntile) ldk(kt + 72, r3);
                if (kt + 32 < ntile) score_tile(kt + 32, r4); if (kt + 40 < ntile) score_tile(kt + 40, r5);
            }
        }
        __syncthreads();
        REP(NREP_SEL)
#pragma unroll 1
        for (int qq = 0; qq < 2; ++qq) {
            const int ql = wid * 2 + qq, n = pos0 + ql + 1; u64* mrow = Mk + (sub * 16 + ql); const float* srow = Sc + ql * SC_LD;
            if (n <= 256) { if (lane < 32) { const int k0 = lane * 64; mrow[lane * 64] = n >= k0 + 64 ? ~0ull : (n > k0 ? ((1ull << (n - k0)) - 1ull) : 0ull); } }
            else if (n <= 512) sa_select<8>(srow, n, mrow, lane);
            else if (n <= 1024) sa_select<16>(srow, n, mrow, lane);
            else if (n <= 1536) sa_select<24>(srow, n, mrow, lane);
            else sa_select<32>(srow, n, mrow, lane);
        }
        __syncthreads();
    }
    REP(NREP_E2) {
    bf16_t* Kl = (bf16_t*)shm; bf16_t* Vl = Kl + 64 * KV_LD;
    const size_t t0 = tb + pos_blk;
    bf16x8 Qb[4][2];
#pragma unroll
    for (int nt = 0; nt < 4; ++nt)
#pragma unroll
        for (int ks = 0; ks < 2; ++ks) Qb[nt][ks] = *(const bf16x8*)(projb + (t0 + nt * 16 + lr) * PROJ_LD + 2048 + wid * 64 + ks * 32 + lq * 8);
    f32x4 O[4][4], Ls[4]; const short one_bf = lr == 0 ? (short)0x3F80 : (short)0; const bf16x8 ones = {one_bf, one_bf, one_bf, one_bf, one_bf, one_bf, one_bf, one_bf};
#pragma unroll
    for (int md = 0; md < 4; ++md)
#pragma unroll
        for (int nt = 0; nt < 4; ++nt) O[md][nt] = (f32x4){0.f, 0.f, 0.f, 0.f};
#pragma unroll
    for (int nt = 0; nt < 4; ++nt) Ls[nt] = (f32x4){0.f, 0.f, 0.f, 0.f};
    const int skey = tid >> 3, sch = tid & 7;
    u32x4 kreg = *(const u32x4*)(projb + (tb + skey) * PROJ_LD + 2560 + sch * 8), vreg = *(const u32x4*)(projb + (tb + skey) * PROJ_LD + 2624 + sch * 8);
#pragma unroll 1
    for (int kt = 0; kt <= qb; ++kt) {
        LDS_BARRIER();
        *(u32x4*)(Kl + skey * KV_LD + sch * 8) = kreg;
        { const unsigned vv[4] = {vreg.x, vreg.y, vreg.z, vreg.w};
#pragma unroll
          for (int x = 0; x < 4; ++x) { Vl[(sch * 8 + 2 * x) * KV_LD + skey] = (bf16_t)(vv[x] & 0xFFFFu); Vl[(sch * 8 + 2 * x + 1) * KV_LD + skey] = (bf16_t)(vv[x] >> 16); } }
        LDS_BARRIER();
        if (kt < qb) { const size_t kr = tb + (size_t)(kt + 1) * 64 + skey; kreg = *(const u32x4*)(projb + kr * PROJ_LD + 2560 + sch * 8); vreg = *(const u32x4*)(projb + kr * PROJ_LD + 2624 + sch * 8); }
        bf16x8 Kf[4][2], Vf[4][2];
#pragma unroll
        for (int m = 0; m < 4; ++m)
#pragma unroll
            for (int k2 = 0; k2 < 2; ++k2) {
                Kf[m][k2] = *(const bf16x8*)(Kl + (m * 16 + lr) * KV_LD + k2 * 32 + lq * 8);
                Vf[m][k2] = cat8(*(const s16x4*)(Vl + (m * 16 + lr) * KV_LD + k2 * 32 + lq * 4), *(const s16x4*)(Vl + (m * 16 + lr) * KV_LD + k2 * 32 + 16 + lq * 4));
            }
#pragma unroll
        for (int nt = 0; nt < 4; ++nt) {
            const u64 mw = Mk[kt * 64 + nt * 16 + lr];
            f32x4 pt[4];
#pragma unroll
            for (int mk = 0; mk < 4; ++mk) {
                f32x4 acc = {-11.541560327111707f, -11.541560327111707f, -11.541560327111707f, -11.541560327111707f};
                acc = MFMA16(Kf[mk][0], Qb[nt][0], acc); acc = MFMA16(Kf[mk][1], Qb[nt][1], acc);
                const int bits = (int)(unsigned)(mw >> (mk * 16 + lq * 4));
#pragma unroll
                for (int j = 0; j < 4; ++j) pt[mk][j] = __uint_as_float(__float_as_uint(__builtin_amdgcn_exp2f(acc[j])) & (unsigned)__builtin_amdgcn_sbfe(bits, j, 1));
            }
            const bf16x8 P0 = packf8(pt[0], pt[1]), P1 = packf8(pt[2], pt[3]);
#pragma unroll
            for (int md = 0; md < 4; ++md) { O[md][nt] = MFMA16(Vf[md][0], P0, O[md][nt]); O[md][nt] = MFMA16(Vf[md][1], P1, O[md][nt]); }
            Ls[nt] = MFMA16(ones, P0, Ls[nt]); Ls[nt] = MFMA16(ones, P1, Ls[nt]);
        }
    }
#pragma unroll
    for (int nt = 0; nt < 4; ++nt) {
        const float l = __shfl(Ls[nt][0], lr); const float inv = __builtin_amdgcn_rcpf(l);
#pragma unroll
        for (int md = 0; md < 4; ++md) *(u32x2*)(ob + (t0 + nt * 16 + lr) * 512 + wid * 64 + md * 16 + lq * 4) = pack4(O[md][nt] * inv);
    }
    __syncthreads();
    }
}
#define XB_TMO      128
#define XB_XCNT(j)  (256  + 64 * (j))
#define XB_XSUB(j)  (1280 + 64 * (j))
#define XB_XGEN(j)  (2304 + 64 * (j))
#define XB_TOP      3328
#define XB_TOPGEN   3392
#define XCD_BAR_WORDS 3456
#define XB_SPIN_CAP (1u << 18)
#define LAS __attribute__((address_space(3)))

__device__ __forceinline__ unsigned xb_ld(unsigned* p)              { return __hip_atomic_load(p, __ATOMIC_RELAXED, __HIP_MEMORY_SCOPE_AGENT); }
__device__ __forceinline__ unsigned xb_add(unsigned* p, unsigned v) { return __hip_atomic_fetch_add(p, v, __ATOMIC_RELAXED, __HIP_MEMORY_SCOPE_AGENT); }
__device__ __forceinline__ unsigned xb_xcc_id() { return (unsigned)__builtin_amdgcn_s_getreg((3 << 11) | 20) & 0xFu; }
#define XB_SPIN(cond, bar) do { unsigned _sp = 0; while (cond) { __builtin_amdgcn_s_sleep(1); \
    if ((++_sp & 255u) == 0u) { if (xb_ld(&(bar)[XB_TMO])) break; if (_sp > XB_SPIN_CAP) { atomicAdd(&(bar)[XB_TMO], 1u); break; } } } } while (0)

struct XcdBarrier {
    unsigned* bar; unsigned x;
    volatile LAS unsigned* st;
};

__device__ __forceinline__ XcdBarrier xcd_barrier_post(unsigned* bar, volatile LAS unsigned* st) {
    XcdBarrier b; b.bar = bar; b.x = xb_xcc_id(); b.st = st;
    if (threadIdx.x == 0) (void)xb_add(&bar[XB_XCNT(b.x)], 1u);
    return b;
}
__device__ __forceinline__ void xcd_barrier_complete(unsigned* bar, unsigned x, unsigned& nloc, unsigned& nx) {
    const unsigned G = gridDim.x * gridDim.y * gridDim.z;
    unsigned sum, cnt, mine, sp = 0u;
    for (;;) {
        sum = 0u; cnt = 0u; mine = 0u;
#pragma unroll
        for (unsigned j = 0; j < 16; ++j) { const unsigned c = xb_ld(&bar[XB_XCNT(j)]); sum += c; cnt += (c > 0u) ? 1u : 0u; mine = (j == x) ? c : mine; }
        if (sum == G) break;
        __builtin_amdgcn_s_sleep(1);
        if ((++sp & 255u) == 0u) { if (xb_ld(&bar[XB_TMO])) break; if (sp > XB_SPIN_CAP) { atomicAdd(&bar[XB_TMO], 1u); break; } }
    }
    nloc = mine > 0u ? mine : 1u; nx = cnt > 0u ? cnt : 1u;
}

__device__ __forceinline__ void xcd_barrier(const XcdBarrier& b) {
    asm volatile("s_waitcnt vmcnt(0)" ::: "memory");
    __syncthreads();
    if (threadIdx.x == 0) {
        unsigned* bar = b.bar;
        __builtin_amdgcn_s_waitcnt(0);
        unsigned nloc = b.st[0], nx = b.st[1];
        if (nloc == 0u) { xcd_barrier_complete(bar, b.x, nloc, nx); b.st[0] = nloc; b.st[1] = nx; }
        const unsigned old = xb_add(&bar[XB_XSUB(b.x)], 1u);
        const unsigned gen = old / nloc;
        if (old + 1u == (gen + 1u) * nloc) {
            __builtin_amdgcn_fence(__ATOMIC_RELEASE, "agent");
            asm volatile("s_waitcnt vmcnt(0)" ::: "memory");
            const unsigned og = xb_add(&bar[XB_TOP], 1u);
            const unsigned tg = og / nx;
            if (og + 1u == (tg + 1u) * nx) xb_add(&bar[XB_TOPGEN], 1u);
            else XB_SPIN(xb_ld(&bar[XB_TOPGEN]) == tg, bar);
            __builtin_amdgcn_fence(__ATOMIC_ACQUIRE, "agent");
            xb_add(&bar[XB_XGEN(b.x)], 1u);
            asm volatile("s_waitcnt vmcnt(0)" ::: "memory");
        } else {
            XB_SPIN(xb_ld(&bar[XB_XGEN(b.x)]) == gen, bar);
            __builtin_amdgcn_fence(__ATOMIC_ACQUIRE, "agent");
            asm volatile("s_waitcnt vmcnt(0)" ::: "memory");
        }
    }
    __syncthreads();
}

#ifndef NREP_PREP
#define NREP_PREP 1
#endif
#ifndef NREP_G1
#define NREP_G1 1
#endif
#ifndef NREP_D1
#define NREP_D1 1
#endif
#ifndef NREP_D2
#define NREP_D2 1
#endif
#ifndef NREP_SA
#define NREP_SA 1
#endif
#ifndef NREP_GN
#define NREP_GN 1
#endif
#ifndef NREP_MIX
#define NREP_MIX 1
#endif
#ifndef NREP_FFU
#define NREP_FFU 1
#endif
typedef const __attribute__((address_space(4))) Params* KParams;
__device__ __forceinline__ Params load_params() {
    Params r{};
#if defined(__HIP_DEVICE_COMPILE__)
    KParams kp = (KParams)__builtin_amdgcn_kernarg_segment_ptr(); asm volatile("" : "+s"(kp));
    r.x = kp->x; r.p = kp->p; r.pos = kp->pos; r.attn_norm = kp->attn_norm; r.w_in = kp->w_in; r.conv_w = kp->conv_w; r.a_log = kp->a_log; r.dt_bias = kp->dt_bias; r.dn_norm = kp->dn_norm; r.q_norm = kp->q_norm; r.k_norm = kp->k_norm;
    r.w_ba = kp->w_ba; r.w_bb = kp->w_bb; r.w_gate = kp->w_gate; r.b_gate = kp->b_gate; r.w_o = kp->w_o; r.ffn_norm = kp->ffn_norm; r.w_fg = kp->w_fg; r.w_fu = kp->w_fu; r.w_fd = kp->w_fd; r.ple_norm = kp->ple_norm; r.w_pg = kp->w_pg; r.w_ple = kp->w_ple;
    r.out = kp->out; r.ws = kp->ws;
#endif
    return r;
}
#define WSP(P, off) ((P).ws + (off))
constexpr size_t OFF_BAR = OFF_MISC + 512 * 1024;
#define GSYNC() do { const Params Pq_ = load_params(); XcdBarrier b_; b_.bar = (unsigned*)(Pq_.ws + OFF_BAR); b_.x = xb_xcc_id(); b_.st = (volatile LAS unsigned*)(shm + LDS_CTRL); xcd_barrier(b_); } while (0)
__global__ void __launch_bounds__(512, 2) mega(Params Punused) {
    extern __shared__ __attribute__((aligned(16))) unsigned char shm[];
    cg::grid_group grid = cg::this_grid();
    PG8_LAS unsigned char* lds = (PG8_LAS unsigned char*)shm; float* ldsf = (float*)shm;
    {
        volatile LAS unsigned* st = (volatile LAS unsigned*)(shm + LDS_CTRL);
        if (threadIdx.x == 0) { st[0] = 0u; st[1] = 0u; }
        __syncthreads();
        const Params P = load_params(); (void)xcd_barrier_post((unsigned*)(P.ws + OFF_BAR), st);
    }
    REP(NREP_PREP) { const Params P = load_params(); phase_prep(P, ldsf); __syncthreads(); }
    { const Params P = load_params(); if (P.ws == nullptr) grid.sync(); }
    GSYNC();
    REP(NREP_G1) { const Params P = load_params();
      run_gemm(lds, (const bf16_t*)WSP(P, OFF_R1), (const bf16_t*)WSP(P, OFF_BT1), 5120, 1024, EpiProj{(bf16_t*)WSP(P, OFF_PROJ), (float*)WSP(P, OFF_SIDE), (bf16_t*)WSP(P, OFF_GATES), P.b_gate}); }
    GSYNC();
    { const Params P = load_params(); phase_tokprep(P, shm); }
    __syncthreads();
    { const Params P = load_params(); const int wid = otid() >> 6; const int tbk = blockIdx.x + 256 * (wid >> 2);
      dn_d1(P, ((tbk >> 5) * 4 + (wid & 3)) * 32 + (tbk & 31), ldsf + wid * 4096); }
    GSYNC();
    if (blockIdx.x < 128) {
        const Params P = load_params(); dn_d2(P, shm);
        if (threadIdx.x == 0) { __builtin_amdgcn_fence(__ATOMIC_RELEASE, "agent"); asm volatile("s_waitcnt vmcnt(0)" ::: "memory"); (void)xb_add((unsigned*)(P.ws + OFF_BAR) + XCD_BAR_WORDS + 32, 1u); }
    }
    {
        const Params P = load_params();
        unsigned* qctr = (unsigned*)(P.ws + OFF_BAR) + XCD_BAR_WORDS + 16; volatile LAS unsigned* qslot = (volatile LAS unsigned*)(shm + LDS_CTRL + 16);
#pragma unroll 1
        for (;;) {
            if (threadIdx.x == 0) *qslot = __hip_atomic_fetch_add(qctr, 1u, __ATOMIC_RELAXED, __HIP_MEMORY_SCOPE_AGENT);
            __syncthreads();
            const unsigned item = *qslot;
            __syncthreads();
            if (item >= 768u) break;
            if (item < 512u) sa_block(P, (int)(item & 15u), 31 - (int)(item >> 4), shm);
            else {
                if (threadIdx.x == 0) { unsigned* dcnt = (unsigned*)(P.ws + OFF_BAR) + XCD_BAR_WORDS + 32; unsigned sp = 0; while (xb_ld(dcnt) < 128u) { __builtin_amdgcn_s_sleep(4); if (++sp > (1u << 22)) break; }
                    __builtin_amdgcn_fence(__ATOMIC_ACQUIRE, "agent"); asm volatile("s_waitcnt vmcnt(0)" ::: "memory"); }
                __syncthreads();
                phase_gnorm(P, (int)item - 512);
            }
        }
    }
    GSYNC();
    REP(NREP_MIX) { const Params P = load_params(); bf16_t* r1 = (bf16_t*)WSP(P, OFF_R1); const bf16_t* gates = (const bf16_t*)WSP(P, OFF_GATES);
      run_gemm(lds, (const bf16_t*)P.out, (const bf16_t*)WSP(P, OFF_BTA), 1024, 512, EpiMixDual{r1, gates}, (const bf16_t*)((unsigned char*)P.out + 32 * MiB), (const bf16_t*)WSP(P, OFF_BTB)); }
    GSYNC();
    { const Params P = load_params();
      run_gemm(lds, (const bf16_t*)WSP(P, OFF_R1), (const bf16_t*)WSP(P, OFF_BTO), 1024, 1024, EpiRes<1>{P.x, nullptr, (bf16_t*)WSP(P, OFF_GATES)  , (float*)WSP(P, OFF_MISC)}); }
    GSYNC();
    REP(NREP_FFU) { const Params P = load_params();
      run_gemm(lds, (const bf16_t*)WSP(P, OFF_GATES)  , (const bf16_t*)WSP(P, OFF_BTF), 5632, 1024, EpiFF{(bf16_t*)WSP(P, OFF_PROJ)  , (const float*)WSP(P, OFF_MISC)}); }
    GSYNC();
    { const Params P = load_params();
      run_gemm(lds, (const bf16_t*)WSP(P, OFF_PROJ)  , (const bf16_t*)WSP(P, OFF_BTD), 1024, 2816, EpiRes<0>{nullptr, (const bf16_t*)WSP(P, OFF_GATES)  , (bf16_t*)WSP(P, OFF_R1)  , (float*)WSP(P, OFF_MISC) + T_TOK});
      run_gemm(lds, (const bf16_t*)WSP(P, OFF_PB), (const bf16_t*)WSP(P, OFF_BTP), 1024, 256, EpiTmp{(bf16_t*)WSP(P, OFF_GATES + 64 * MiB)}); }
    GSYNC();
    { const Params P = load_params();
      run_gemm(lds, (const bf16_t*)WSP(P, OFF_R1), (const bf16_t*)WSP(P, OFF_BTPG), 1024, 1024, EpiPle{P.out, (const bf16_t*)WSP(P, OFF_R1)  , (const bf16_t*)WSP(P, OFF_GATES + 64 * MiB)  , (const float*)WSP(P, OFF_MISC) + T_TOK}); }
}

extern "C" void kernel_launch(void* const* d_in, const int* in_sizes, int n_in, void* d_out, int out_size, void* d_ws, size_t ws_size, hipStream_t stream) {
    static int grid_blocks = 0;
    if (!grid_blocks) {
        int dev = 0, cus = 0, per_cu = 0;
        hipGetDevice(&dev); hipDeviceGetAttribute(&cus, hipDeviceAttributeMultiprocessorCount, dev);
        if (hipFuncSetAttribute((const void*)mega, hipFuncAttributeMaxDynamicSharedMemorySize, LDS_BYTES) != hipSuccess) fprintf(stderr, "hipFuncSetAttribute failed\n");
        hipOccupancyMaxActiveBlocksPerMultiprocessor(&per_cu, (const void*)mega, 512, LDS_BYTES);
        if (per_cu < 1) per_cu = 1;
        grid_blocks = 256;
        if (ws_size < WS_END) fprintf(stderr, "workspace too small: %zu < %zu\n", ws_size, (size_t)WS_END);
    }
    Params P{};
    const float* const* f = (const float* const*)d_in;
    P.x = f[0]; P.p = f[1]; P.pos = (const int*)d_in[2]; P.attn_norm = f[3]; P.w_in = f[4]; P.conv_w = f[5]; P.a_log = f[6]; P.dt_bias = f[7]; P.dn_norm = f[8]; P.q_norm = f[9]; P.k_norm = f[10];
    P.w_ba = f[11]; P.w_bb = f[12]; P.w_gate = f[13]; P.b_gate = f[14]; P.w_o = f[15]; P.ffn_norm = f[16]; P.w_fg = f[17]; P.w_fu = f[18]; P.w_fd = f[19]; P.ple_norm = f[20]; P.w_pg = f[21]; P.w_ple = f[22];
    P.out = (float*)d_out; P.ws = (unsigned char*)d_ws;
    (void)hipMemsetAsync((unsigned char*)d_ws + OFF_BAR, 0, (XCD_BAR_WORDS + 64) * sizeof(unsigned), stream);
    void* args[] = {&P};
    hipError_t e = hipLaunchCooperativeKernel((const void*)mega, dim3(grid_blocks), dim3(512), args, LDS_BYTES, stream);
    if (e != hipSuccess) fprintf(stderr, "cooperative launch failed: %s (grid %d)\n", hipGetErrorString(e), grid_blocks);
}
```

```cpp
#include <hip/hip_runtime.h>
#include <hip/hip_cooperative_groups.h>
#include <cstdio>
namespace cg = cooperative_groups;
__device__ __forceinline__ int otid() { int t = (int)threadIdx.x; asm volatile("" : "+v"(t)); return t; }
namespace pg8 {
#define PG8_LAS __attribute__((address_space(3)))
typedef unsigned short bf16_t;
typedef short bf16x8 __attribute__((ext_vector_type(8)));
typedef float f32x4 __attribute__((ext_vector_type(4)));
typedef unsigned u32x4 __attribute__((ext_vector_type(4)));
constexpr int BM = 256, BK = 64, HALF = 128, HTB = HALF * BK * 2  , STAGE_BYTES = 8 * HTB, NXCD = 8, WGM = 8;

__host__ __device__ __forceinline__ int lds_byte(int r, int c) { const int st = (r >> 4) * 2 + (c >> 5), rr = r & 15, cc = c & 31, ob = rr * 64 + cc * 2; return st * 1024 + (ob ^ (((ob >> 9) & 1) << 5)); }
__host__ __device__ __forceinline__ void stage_rc(int b, int& R, int& C) { const int st = b / 1024, sb = b % 1024, swz = sb ^ (((sb >> 9) & 1) << 5); R = (st >> 1) * 16 + swz / 64; C = (st & 1) * 32 + (swz % 64) / 2; }
__host__ __device__ __forceinline__ int perm32(int rho) { const int n = rho >> 4, i = rho & 15; return 8 * (i >> 2) + 4 * n + (i & 3); }

struct Unit { int pm, pn; };
struct Gemm { const bf16_t* A; const bf16_t* Bt; int M, N, K; const bf16_t* A2; const bf16_t* Bt2; };

struct StaticOrder {
    int nM, nN, nwg, G, c;
    __host__ __device__ void init(int M, int N, int G_, int c_) { nM = M / BM; nN = N / BM; nwg = nM * nN; G = G_; c = c_; }
    __host__ __device__ bool next(int i, Unit& u) const {
        const long L = (long)i * G + c; if (L >= nwg) return false;
        int wgid = (int)L; { const int q = nwg / NXCD, r = nwg % NXCD, xcd = wgid % NXCD, off = wgid / NXCD; wgid = (xcd < r ? xcd * (q + 1) : r * (q + 1) + (xcd - r) * q) + off; }
        const int nig = WGM * nN, gid = wgid / nig, fm = gid * WGM, gsz = (nM - fm) < WGM ? (nM - fm) : WGM;
        u.pm = fm + ((wgid % nig) % gsz); u.pn = (wgid % nig) / gsz; return true;
    }
    __device__ __forceinline__ void a_ready(const Unit&) const {}
    __device__ __forceinline__ void done(const Unit&) const {}
};
__device__ __forceinline__ unsigned cvt_pk_bf16(float lo, float hi) { unsigned r; asm volatile("v_cvt_pk_bf16_f32 %0, %1, %2" : "=v"(r) : "v"(lo), "v"(hi)); return r; }
typedef float f32x2 __attribute__((ext_vector_type(2)));
template <class Epi, class Sched>
__device__ __forceinline__ void gemm_phase(PG8_LAS unsigned char* lds, const Gemm g, const Sched& S, const Epi& E) {
    const int tid = otid(), wid = __builtin_amdgcn_readfirstlane(tid >> 6), lane = tid & 63, wr = wid >> 2, wc = wid & 3, fr = lane & 15, fq = lane >> 4;
    const int K = g.K, nt = Epi::DUAL ? 2 * (K / BK) : K / BK, nth = nt / 2;
    unsigned voffA[2], voffB[2];
#pragma unroll
    for (int i = 0; i < 2; ++i) { int R, C; stage_rc(tid * 16 + i * 8192, R, C); const int Rb = Epi::PERM ? ((R & ~31) + perm32(R & 31)) : R;
        voffA[i] = (unsigned)(R * K + C) * 2u; voffB[i] = (unsigned)(Rb * K + C) * 2u; }
    const size_t kstep = (size_t)(BK * 2);
    const size_t hstep = (size_t)HALF * K * 2;
    const size_t tstep = 2 * hstep;
    const unsigned ldsw = (unsigned)wid * 1024u;
    const int aoff = lds_byte(wr * 64 + fr, fq * 8), boff = lds_byte(wc * 32 + fr, fq * 8);
#define PG8_SA(b, h) (((b) * 2 + (h)) * HTB)
#define PG8_SB(b, h) ((4 + (b) * 2 + (h)) * HTB)
#define PG8_STAGE(bufoff, gbase, voff) do { _Pragma("unroll") for (int _i = 0; _i < 2; ++_i) \
        __builtin_amdgcn_global_load_lds((const unsigned*)((const char*)(gbase) + (voff)[_i]), (PG8_LAS unsigned*)(lds + (bufoff) + ldsw + _i * 8192), 16, 0, 0); } while (0)
#define PG8_LDA(dst, b, h) do { _Pragma("unroll") for (int m = 0; m < 4; ++m) _Pragma("unroll") for (int k = 0; k < 2; ++k) dst[m][k] = *(const PG8_LAS bf16x8*)(lds + PG8_SA(b, h) + aoff + m * 2048 + k * 1024); } while (0)
#define PG8_LDB(dst, b, h) do { _Pragma("unroll") for (int n = 0; n < 2; ++n) _Pragma("unroll") for (int k = 0; k < 2; ++k) dst[n][k] = *(const PG8_LAS bf16x8*)(lds + PG8_SB(b, h) + boff + n * 2048 + k * 1024); } while (0)
#define PG8_MMA(ai, bj, At, Bt) do { __builtin_amdgcn_s_setprio(1); _Pragma("unroll") for (int m = 0; m < 4; ++m) _Pragma("unroll") for (int n = 0; n < 2; ++n) _Pragma("unroll") for (int k = 0; k < 2; ++k) \
        acc[ai][bj][m][n] = __builtin_amdgcn_mfma_f32_16x16x32_bf16(Bt[n][k], At[m][k], acc[ai][bj][m][n], 0, 0, 0); __builtin_amdgcn_s_setprio(0); } while (0)
#define PG8_WAIT_V(n) asm volatile("s_waitcnt vmcnt(" #n ")" ::: "memory")
#define PG8_WAIT_L(n) asm volatile("s_waitcnt lgkmcnt(" #n ")" ::: "memory")
#define PG8_BAR __builtin_amdgcn_s_barrier()
#define PG8_SCHED __builtin_amdgcn_sched_barrier(0)
    Unit cur, nxt; int ui = 0;
    if (!S.next(0, cur)) return;
    f32x4 acc[2][2][4][2];
#pragma unroll
    for (int a = 0; a < 2; ++a)
#pragma unroll
        for (int b = 0; b < 2; ++b)
#pragma unroll
            for (int m = 0; m < 4; ++m)
#pragma unroll
                for (int n = 0; n < 2; ++n) acc[a][b][m][n] = (f32x4){0.f, 0.f, 0.f, 0.f};
    bf16x8 At[4][2], B0[2][2], B1[2][2];
    const char* cA = (const char*)g.A + (size_t)cur.pm * tstep; const char* cB = (const char*)g.Bt + (size_t)cur.pn * tstep;
    const char* cA2 = Epi::DUAL ? (const char*)g.A2 + (size_t)cur.pm * tstep : cA; const char* cB2 = Epi::DUAL ? (const char*)g.Bt2 + (size_t)cur.pn * tstep : cB;
#define PG8_KP(b1, b2, t) ((Epi::DUAL && (t) >= nth) ? (b2) + (size_t)((t) - nth) * kstep : (b1) + (size_t)(t) * kstep)
    S.a_ready(cur);
    PG8_STAGE(PG8_SB(0, 0), cB, voffB); PG8_STAGE(PG8_SA(0, 0), cA, voffA); PG8_STAGE(PG8_SB(0, 1), cB + hstep, voffB); PG8_STAGE(PG8_SA(0, 1), cA + hstep, voffA);
    if (wr == 1) PG8_BAR;
    PG8_WAIT_V(4); PG8_BAR;
    PG8_STAGE(PG8_SB(1, 0), cB + kstep, voffB); PG8_STAGE(PG8_SA(1, 0), cA + kstep, voffA); PG8_STAGE(PG8_SB(1, 1), cB + hstep + kstep, voffB);
    PG8_WAIT_V(6); PG8_BAR;
    for (;;) {
        const bool has_next = S.next(ui + 1, nxt);
        const char* nA = has_next ? (const char*)g.A + (size_t)nxt.pm * tstep : cA; const char* nB = has_next ? (const char*)g.Bt + (size_t)nxt.pn * tstep : cB;
        for (int t = 0; t < nt; t += 2) {
            const bool last = (t == nt - 2);
            if constexpr (Epi::DUAL) { if (t == nth) E.mid(acc, cur, wr, wc, fr, fq); }
            const char* a1 = PG8_KP(cA, cA2, t + 1);
            const char* a2 = last ? nA : PG8_KP(cA, cA2, t + 2); const char* b2 = last ? nB : PG8_KP(cB, cB2, t + 2);
            const char* a3 = a2 + kstep; const char* b3 = b2 + kstep;
            if (last && has_next) S.a_ready(nxt);
            PG8_LDB(B0, 0, 0); PG8_SCHED; PG8_LDA(At, 0, 0); PG8_STAGE(PG8_SA(1, 1), a1 + hstep, voffA);
            PG8_WAIT_L(8); PG8_BAR; PG8_WAIT_L(0); PG8_MMA(0, 0, At, B0); PG8_BAR; PG8_SCHED;
            PG8_LDB(B1, 0, 1); PG8_STAGE(PG8_SB(0, 0), b2, voffB);
            PG8_BAR; PG8_WAIT_L(0); PG8_MMA(0, 1, At, B1); PG8_BAR;
            PG8_LDA(At, 0, 1); PG8_STAGE(PG8_SA(0, 0), a2, voffA);
            PG8_BAR; PG8_WAIT_L(0); PG8_MMA(1, 0, At, B0); PG8_BAR; PG8_SCHED;
            PG8_STAGE(PG8_SB(0, 1), b2 + hstep, voffB);
            PG8_WAIT_V(6); PG8_BAR; PG8_MMA(1, 1, At, B1); PG8_BAR;
            PG8_LDB(B0, 1, 0); PG8_SCHED; PG8_LDA(At, 1, 0); PG8_STAGE(PG8_SA(0, 1), a2 + hstep, voffA);
            PG8_WAIT_L(8); PG8_BAR; PG8_WAIT_L(0); PG8_MMA(0, 0, At, B0); PG8_BAR; PG8_SCHED;
            PG8_LDB(B1, 1, 1); PG8_STAGE(PG8_SB(1, 0), b3, voffB);
            PG8_BAR; PG8_WAIT_L(0); PG8_MMA(0, 1, At, B1); PG8_BAR;
            PG8_LDA(At, 1, 1); PG8_STAGE(PG8_SA(1, 0), a3, voffA);
            PG8_BAR; PG8_WAIT_L(0); PG8_MMA(1, 0, At, B0); PG8_BAR; PG8_SCHED;
            PG8_STAGE(PG8_SB(1, 1), b3 + hstep, voffB);
            PG8_WAIT_V(6); PG8_BAR; PG8_MMA(1, 1, At, B1); PG8_BAR;
        }
        if constexpr (!Epi::AFTER_DRAIN) { E(acc, cur, wr, wc, fr, fq); S.done(cur); }
        if (!has_next) break;
#pragma unroll
        for (int a = 0; a < 2; ++a)
#pragma unroll
            for (int b = 0; b < 2; ++b)
#pragma unroll
                for (int m = 0; m < 4; ++m)
#pragma unroll
                    for (int n = 0; n < 2; ++n) acc[a][b][m][n] = (f32x4){0.f, 0.f, 0.f, 0.f};
        cur = nxt; cA = nA; cB = nB; ++ui;
        if constexpr (Epi::DUAL) { cA2 = (const char*)g.A2 + (size_t)cur.pm * tstep; cB2 = (const char*)g.Bt2 + (size_t)cur.pn * tstep; }
    }
    PG8_WAIT_V(0);
    if (wr == 0) PG8_BAR;
    PG8_BAR;
    if constexpr (Epi::AFTER_DRAIN) { E.fused(acc, cur, wr, wc, fr, fq, lds, wid, lane); S.done(cur); }
#undef PG8_SA
#undef PG8_KP
#undef PG8_SB
#undef PG8_STAGE
#undef PG8_LDA
#undef PG8_LDB
#undef PG8_MMA
#undef PG8_WAIT_V
#undef PG8_WAIT_L
#undef PG8_BAR
#undef PG8_SCHED
}
}
using pg8::bf16_t; using pg8::f32x4; using pg8::u32x4; using pg8::Unit; using pg8::cvt_pk_bf16;
typedef unsigned long long u64;
typedef unsigned u32x2 __attribute__((ext_vector_type(2)));

constexpr int T_TOK = 32768, SEQ = 2048, NB = 16, DM = 1024, DFF = 2816;
constexpr int PROJ_LD = 2688, SIDE_LD = 384;
constexpr size_t MiB = 1ull << 20;
constexpr size_t OFF_BT1 = 0, OFF_BTA = 10 * MiB, OFF_BTB = 11 * MiB, OFF_BTO = 12 * MiB, OFF_BTF = 14 * MiB, OFF_BTD = 25 * MiB, OFF_BTPG = 31 * MiB, OFF_BTP = 33 * MiB,
                 OFF_MISC = 34 * MiB, OFF_BG = 35 * MiB, OFF_R1 = 36 * MiB, OFF_PB = 100 * MiB, OFF_PROJ = 116 * MiB, OFF_SIDE = 284 * MiB, OFF_GATES = 332 * MiB, WS_END = 460 * MiB;
constexpr int SC_LD = 2064;
constexpr int LDS_MASK = 16 * SC_LD * 4, LDS_CTRL = LDS_MASK + 16384, LDS_BYTES = LDS_CTRL + 64;

struct Params {
    const float *x, *p; const int* pos;
    const float *attn_norm, *w_in, *conv_w, *a_log, *dt_bias, *dn_norm, *q_norm, *k_norm, *w_ba, *w_bb, *w_gate, *b_gate, *w_o, *ffn_norm, *w_fg, *w_fu, *w_fd, *ple_norm, *w_pg, *w_ple;
    float* out; unsigned char* ws;
};

__device__ __forceinline__ float bf2f(unsigned short b) { return __uint_as_float(((unsigned)b) << 16); }
__device__ __forceinline__ unsigned short f2bf(float f) { const __bf16 v = (__bf16)f; return __builtin_bit_cast(unsigned short, v); }
__device__ __forceinline__ float bflo(unsigned u) { return __uint_as_float(u << 16); }
__device__ __forceinline__ float bfhi(unsigned u) { return __uint_as_float(u & 0xFFFF0000u); }
typedef __bf16 hbf16x2 __attribute__((ext_vector_type(2)));
typedef float hf32x2 __attribute__((ext_vector_type(2)));
__device__ __forceinline__ unsigned pack2(float a, float b) { const hf32x2 f = {a, b}; const hbf16x2 v = __builtin_convertvector(f, hbf16x2); return __builtin_bit_cast(unsigned, v); }
__device__ __forceinline__ float sigmoidf_(float v) { return __builtin_amdgcn_rcpf(1.0f + __builtin_amdgcn_exp2f(v * -1.4426950408889634f)); }
__device__ __forceinline__ float siluf_(float v) { return v * __builtin_amdgcn_rcpf(1.0f + __builtin_amdgcn_exp2f(v * -1.4426950408889634f)); }
__device__ __forceinline__ float wave_sum(float v) {
#pragma unroll
    for (int o = 32; o >= 1; o >>= 1) v += __shfl_xor(v, o);
    return v;
}

__device__ __forceinline__ int win_map(int n) {
    if (n < 2048) return n;
    if (n < 2560) return n + 8;
    if (n < 2688) return n + 8;
    if (n < 2752) return n - 2688 + 2952;
    if (n < 2756) return n - 2752 + 3016;
    if (n < 2764) return n - 2756 + 2048;
    if (n < 2816) return -1;
    return n - 2816 + 2696;
}
struct TJob { int kind; const float* s0; const float* s1; int ld; int K; int N; const float* gain; bf16_t* dst; };
struct TLoad { float v[8]; bf16_t* tbase; int K; };
__device__ __forceinline__ void tile_load(const TJob& j, int t, int tid, TLoad& L) {
    const int nkt = j.K / 64; const int kt = t % nkt, ntl = t / nkt, n = tid & 63, kc = tid >> 6, dn = ntl * 64 + n, k0 = kt * 64 + kc * 8;
    const float* sp = j.s0; int sc = dn, ld = j.ld;
    if (j.kind == 0) { if (dn < 3072) sc = win_map(dn); else { sp = j.s1; sc = dn - 3072; ld = 2048; } }
    else if (j.kind == 2) { const int tl = dn >> 8, w = dn & 255; if (w < 128) sc = tl * 128 + w; else { sp = j.s1; sc = tl * 128 + w - 128; } }
    L.tbase = j.dst + (size_t)(ntl * 64) * j.K + kt * 64; L.K = j.K;
#pragma unroll
    for (int i = 0; i < 8; ++i) { float v = 0.f; if (sc >= 0) { v = sp[(size_t)(k0 + i) * ld + sc]; if (j.gain) v *= j.gain[k0 + i]; } L.v[i] = v; }
}
__device__ __forceinline__ void tile_stage(const TLoad& L, bf16_t* lb, int tid) {
    u32x4 w; w.x = pack2(L.v[0], L.v[1]); w.y = pack2(L.v[2], L.v[3]); w.z = pack2(L.v[4], L.v[5]); w.w = pack2(L.v[6], L.v[7]); *(u32x4*)(lb + (tid & 63) * 72 + (tid >> 6) * 8) = w;
}
__device__ __forceinline__ void tile_flush(const TLoad& L, const bf16_t* lb, int tid) {
    const int row = tid >> 3, piece = tid & 7; *(u32x4*)(L.tbase + (size_t)row * L.K + piece * 8) = *(const u32x4*)(lb + row * 72 + piece * 8);
}
__device__ __forceinline__ TJob get_job(const Params& P, int& t) {
    unsigned char* ws = P.ws;
    if (t < 1280) return TJob{0, P.w_in, P.w_gate, 3020, 1024, 5120, nullptr, (bf16_t*)(ws + OFF_BT1)}; t -= 1280;
    if (t < 128) return TJob{1, P.w_ba, nullptr, 1024, 512, 1024, nullptr, (bf16_t*)(ws + OFF_BTA)}; t -= 128;
    if (t < 128) return TJob{1, P.w_bb, nullptr, 1024, 512, 1024, nullptr, (bf16_t*)(ws + OFF_BTB)}; t -= 128;
    if (t < 256) return TJob{1, P.w_o, nullptr, 1024, 1024, 1024, nullptr, (bf16_t*)(ws + OFF_BTO)}; t -= 256;
    if (t < 1408) return TJob{2, P.w_fg, P.w_fu, 2816, 1024, 5632, P.ffn_norm, (bf16_t*)(ws + OFF_BTF)}; t -= 1408;
    if (t < 704) return TJob{1, P.w_fd, nullptr, 1024, 2816, 1024, nullptr, (bf16_t*)(ws + OFF_BTD)}; t -= 704;
    if (t < 256) return TJob{1, P.w_pg, nullptr, 1024, 1024, 1024, P.ple_norm, (bf16_t*)(ws + OFF_BTPG)}; t -= 256;
    return TJob{1, P.w_ple, nullptr, 1024, 256, 1024, nullptr, (bf16_t*)(ws + OFF_BTP)};
}
constexpr int N_TTILES = 1280 + 128 + 128 + 256 + 1408 + 704 + 256 + 64;

__device__ __forceinline__ void phase_prep(const Params& P, float* lds) {
    unsigned char* ws = P.ws;
    {
        const int tid0 = otid(), G = gridDim.x;
#pragma unroll 1
        for (int t = blockIdx.x; t < N_TTILES; t += 2 * G) {
            int ta = t, tb2 = t + G; const bool hb = tb2 < N_TTILES;
            const TJob ja = get_job(P, ta); TLoad La, Lb; tile_load(ja, ta, tid0, La);
            if (hb) { const TJob jb = get_job(P, tb2); tile_load(jb, tb2, tid0, Lb); }
            bf16_t* lbA = (bf16_t*)lds; bf16_t* lbB = lbA + 64 * 72;
            tile_stage(La, lbA, tid0); if (hb) tile_stage(Lb, lbB, tid0);
            __syncthreads();
            tile_flush(La, lbA, tid0); if (hb) tile_flush(Lb, lbB, tid0);
            __syncthreads();
        }
    }
    const int tid = otid(), lane = tid & 63, wid = tid >> 6, gw = blockIdx.x * 8 + wid, nw = gridDim.x * 8;
    bf16_t* h = (bf16_t*)(ws + OFF_R1);
#pragma unroll 1
    for (int r0 = gw; r0 < T_TOK; r0 += 2 * nw) {
        float4 v[2][4]; float ss[2];
#pragma unroll
        for (int q = 0; q < 2; ++q) { const float4* xr = (const float4*)(P.x + (size_t)(r0 + q * nw) * DM); ss[q] = 0.f;
#pragma unroll
            for (int i = 0; i < 4; ++i) { const f32x4 t_ = __builtin_nontemporal_load((const f32x4*)xr + i * 64 + lane); v[q][i] = make_float4(t_[0], t_[1], t_[2], t_[3]); ss[q] += v[q][i].x * v[q][i].x + v[q][i].y * v[q][i].y + v[q][i].z * v[q][i].z + v[q][i].w * v[q][i].w; } }
#pragma unroll
        for (int q = 0; q < 2; ++q) {
            const float rstd = rsqrtf(wave_sum(ss[q]) * (1.0f / DM) + 1e-6f);
#pragma unroll
            for (int i = 0; i < 4; ++i) {
                const float4 g = ((const float4*)P.attn_norm)[i * 64 + lane];
                u32x2 o; o.x = pack2(v[q][i].x * rstd * g.x, v[q][i].y * rstd * g.y); o.y = pack2(v[q][i].z * rstd * g.z, v[q][i].w * rstd * g.w);
                *(u32x2*)(h + (size_t)(r0 + q * nw) * DM + (i * 64 + lane) * 4) = o;
            }
        }
    }
    bf16_t* pb = (bf16_t*)(ws + OFF_PB);
    {
        const size_t nth = (size_t)gridDim.x * 512, n4 = (size_t)T_TOK * 256 / 4;
#pragma unroll 1
        for (size_t i = (size_t)blockIdx.x * 512 + tid; i < n4; i += 4 * nth) {
            float4 v[4];
#pragma unroll
            for (int q = 0; q < 4; ++q) v[q] = ((const float4*)P.p)[i + q * nth];
#pragma unroll
            for (int q = 0; q < 4; ++q) { u32x2 o; o.x = pack2(v[q].x, v[q].y); o.y = pack2(v[q].z, v[q].w); ((u32x2*)pb)[i + q * nth] = o; }
        }
    }
    float* rs = (float*)(ws + OFF_MISC);
    for (int i = blockIdx.x * 512 + tid; i < 2 * T_TOK; i += gridDim.x * 512) rs[i] = 0.f;
}
#define EPI_LOOP_BEGIN \
    _Pragma("unroll") for (int ai = 0; ai < 2; ++ai) _Pragma("unroll") for (int m = 0; m < 4; ++m) { const int row = u.pm * 256 + ai * 128 + wr * 64 + m * 16 + fr; \
    _Pragma("unroll") for (int bj = 0; bj < 2; ++bj) { const int col = u.pn * 256 + bj * 128 + wc * 32 + fq * 8; f32x4 v0 = acc[ai][bj][m][0], v1 = acc[ai][bj][m][1];
#define EPI_LOOP_END } }
__device__ __forceinline__ u32x2 pack4(const f32x4& a) { u32x2 w; w.x = pack2(a[0], a[1]); w.y = pack2(a[2], a[3]); return w; }
__device__ __forceinline__ u32x4 pack8(const f32x4& a, const f32x4& b) { u32x4 w; w.x = pack2(a[0], a[1]); w.y = pack2(a[2], a[3]); w.z = pack2(b[0], b[1]); w.w = pack2(b[2], b[3]); return w; }
__device__ __forceinline__ void unpack8(const u32x4& w, f32x4& a, f32x4& b) { a[0] = bflo(w.x); a[1] = bfhi(w.x); a[2] = bflo(w.y); a[3] = bfhi(w.y); b[0] = bflo(w.z); b[1] = bfhi(w.z); b[2] = bflo(w.w); b[3] = bfhi(w.w); }

struct EpiProj {
    static constexpr bool PERM = true, AFTER_DRAIN = false, DUAL = false;
    bf16_t* projb; float* side; bf16_t* gates; const float* bgate;
    __device__ __forceinline__ void operator()(const f32x4 (&acc)[2][2][4][2], const Unit& u, int wr, int wc, int fr, int fq) const {
        EPI_LOOP_BEGIN
            if (u.pn < 12) {
                if (col < PROJ_LD) *(u32x4*)(projb + (size_t)row * PROJ_LD + col) = pack8(v0, v1);
                else { float* sp = side + (size_t)row * SIDE_LD + (col - PROJ_LD); *(f32x4*)sp = v0; *(f32x4*)(sp + 4) = v1; }
            } else {
                const int gc = col - 3072; const f32x4 b0 = *(const f32x4*)(bgate + gc), b1 = *(const f32x4*)(bgate + gc + 4);
#pragma unroll
                for (int j = 0; j < 4; ++j) { v0[j] = sigmoidf_(v0[j] + b0[j]); v1[j] = sigmoidf_(v1[j] + b1[j]); }
                *(u32x4*)(gates + (size_t)row * 2048 + gc) = pack8(v0, v1);
            }
        EPI_LOOP_END
    }
};
struct EpiMixDual {
    static constexpr bool PERM = true, AFTER_DRAIN = false, DUAL = true;
    bf16_t* merged; const bf16_t* gates;
    __device__ __forceinline__ void mid(f32x4 (&acc)[2][2][4][2], const Unit& u, int wr, int wc, int fr, int fq) const {
#pragma unroll
        for (int ai = 0; ai < 2; ++ai)
#pragma unroll
            for (int m = 0; m < 4; ++m) { const int row = u.pm * 256 + ai * 128 + wr * 64 + m * 16 + fr;
#pragma unroll
                for (int bj = 0; bj < 2; ++bj) { const int col = u.pn * 256 + bj * 128 + wc * 32 + fq * 8;
                    f32x4 a0, a1, b0, b1; unpack8(*(const u32x4*)(gates + (size_t)row * 2048 + col), a0, a1); unpack8(*(const u32x4*)(gates + (size_t)row * 2048 + 1024 + col), b0, b1);
#pragma unroll
                    for (int j = 0; j < 4; ++j) { acc[ai][bj][m][0][j] *= a0[j] * __builtin_amdgcn_rcpf(b0[j]); acc[ai][bj][m][1][j] *= a1[j] * __builtin_amdgcn_rcpf(b1[j]); } } }
    }
    __device__ __forceinline__ void operator()(const f32x4 (&acc)[2][2][4][2], const Unit& u, int wr, int wc, int fr, int fq) const {
        EPI_LOOP_BEGIN
            f32x4 g0, g1; unpack8(*(const u32x4*)(gates + (size_t)row * 2048 + 1024 + col), g0, g1);
            *(u32x4*)(merged + (size_t)row * DM + col) = pack8(v0 * g0, v1 * g1);
        EPI_LOOP_END
    }
};
template <int FIRST> struct EpiRes {
    static constexpr bool PERM = true, AFTER_DRAIN = false, DUAL = false;
    const float* xf; const bf16_t* xbi; bf16_t* xb; float* rowss;
    __device__ __forceinline__ void operator()(const f32x4 (&acc)[2][2][4][2], const Unit& u, int wr, int wc, int fr, int fq) const {
#pragma unroll
        for (int ai = 0; ai < 2; ++ai)
#pragma unroll
            for (int m = 0; m < 4; ++m) {
                const int row = u.pm * 256 + ai * 128 + wr * 64 + m * 16 + fr; float ss = 0.f;
#pragma unroll
                for (int bj = 0; bj < 2; ++bj) {
                    const int col = u.pn * 256 + bj * 128 + wc * 32 + fq * 8; const f32x4 v0 = acc[ai][bj][m][0], v1 = acc[ai][bj][m][1];
                    f32x4 r0, r1;
                    if (FIRST) { const float* ip = xf + (size_t)row * DM + col; r0 = __builtin_nontemporal_load((const f32x4*)ip); r1 = __builtin_nontemporal_load((const f32x4*)(ip + 4)); }
                    else unpack8(*(const u32x4*)(xbi + (size_t)row * DM + col), r0, r1);
                    r0 += v0; r1 += v1;
                    *(u32x4*)(xb + (size_t)row * DM + col) = pack8(r0, r1);
                    ss += r0[0] * r0[0] + r0[1] * r0[1] + r0[2] * r0[2] + r0[3] * r0[3] + r1[0] * r1[0] + r1[1] * r1[1] + r1[2] * r1[2] + r1[3] * r1[3];
                }
                ss += __shfl_xor(ss, 16); ss += __shfl_xor(ss, 32);
                if (fq == 0) atomicAdd(rowss + row, ss);
            }
    }
};
struct EpiFF {
    static constexpr bool PERM = true, AFTER_DRAIN = false, DUAL = false;
    bf16_t* ff; const float* rowss;
    __device__ __forceinline__ void operator()(const f32x4 (&acc)[2][2][4][2], const Unit& u, int wr, int wc, int fr, int fq) const {
#pragma unroll
        for (int ai = 0; ai < 2; ++ai)
#pragma unroll
            for (int m = 0; m < 4; ++m) {
                const int row = u.pm * 256 + ai * 128 + wr * 64 + m * 16 + fr, col = u.pn * 128 + wc * 32 + fq * 8;
                const float rstd = rsqrtf(rowss[row] * (1.0f / DM) + 1e-6f);
                f32x4 o0, o1;
#pragma unroll
                for (int j = 0; j < 4; ++j) { o0[j] = siluf_(acc[ai][0][m][0][j] * rstd) * (acc[ai][1][m][0][j] * rstd); o1[j] = siluf_(acc[ai][0][m][1][j] * rstd) * (acc[ai][1][m][1][j] * rstd); }
                *(u32x4*)(ff + (size_t)row * DFF + col) = pack8(o0, o1);
            }
    }
};
struct EpiTmp {
    static constexpr bool PERM = true, AFTER_DRAIN = false, DUAL = false;
    bf16_t* o;
    __device__ __forceinline__ void operator()(const f32x4 (&acc)[2][2][4][2], const Unit& u, int wr, int wc, int fr, int fq) const {
        EPI_LOOP_BEGIN
            *(u32x4*)(o + (size_t)row * DM + col) = pack8(v0, v1);
        EPI_LOOP_END
    }
};
struct EpiPle {
    static constexpr bool PERM = true, AFTER_DRAIN = false, DUAL = false;
    float* o; const bf16_t* x2b; const bf16_t* tmp; const float* rowss;
    __device__ __forceinline__ void operator()(const f32x4 (&acc)[2][2][4][2], const Unit& u, int wr, int wc, int fr, int fq) const {
        EPI_LOOP_BEGIN
            const float rstd = rsqrtf(rowss[row] * (1.0f / DM) + 1e-6f);
            float* op = o + (size_t)row * DM + col;
            f32x4 x0, x1, t0, t1; unpack8(*(const u32x4*)(x2b + (size_t)row * DM + col), x0, x1); unpack8(*(const u32x4*)(tmp + (size_t)row * DM + col), t0, t1);
#pragma unroll
            for (int j = 0; j < 4; ++j) { x0[j] += sigmoidf_(v0[j] * rstd) * t0[j]; x1[j] += sigmoidf_(v1[j] * rstd) * t1[j]; }
            __builtin_nontemporal_store(x0, (f32x4*)op); __builtin_nontemporal_store(x1, (f32x4*)(op + 4));
        EPI_LOOP_END
    }
};
template <class Epi> __device__ __forceinline__ void run_gemm(PG8_LAS unsigned char* lds, const bf16_t* A, const bf16_t* Bt, int N, int K, const Epi& E, const bf16_t* A2 = nullptr, const bf16_t* Bt2 = nullptr) {
    pg8::Gemm g{A, Bt, T_TOK, N, K, A2, Bt2}; pg8::StaticOrder S; S.init(T_TOK, N, (int)gridDim.x, (int)blockIdx.x);
    __syncthreads();
    pg8::gemm_phase<Epi, pg8::StaticOrder>(lds, g, S, E);
    __syncthreads();
}
__constant__ float c_inv_freq[8] = {1.0f, 0.19392274f, 0.03760603f, 0.0072926646f, 0.0014142136f, 0.0002742482f, 5.3182957e-05f, 1.0313385e-05f};
#ifndef NREP_CONV
#define NREP_CONV 1
#endif
#ifndef REP
#define REP(n) _Pragma("unroll 1") for (int rep_ = 0; rep_ < (n); ++rep_)
#endif
__device__ __forceinline__ void phase_tokprep(const Params& P, unsigned char* shm) {
    unsigned char* ws = P.ws;
    bf16_t* projb = (bf16_t*)(ws + OFF_PROJ); float* side = (float*)(ws + OFF_SIDE); float* bg = (float*)(ws + OFF_BG);
    bf16_t* qk = (bf16_t*)(ws + OFF_R1); bf16_t* vT = (bf16_t*)((unsigned char*)P.out + 64 * MiB); bf16_t* kT = (bf16_t*)((unsigned char*)P.out + 96 * MiB);
    const int tid = otid(), lane = tid & 63, wid = tid >> 6, gw = blockIdx.x * 8 + wid, nw = gridDim.x * 8;
#pragma unroll 1
    for (int oct = gw; oct < T_TOK / 8; oct += nw) {
        const int t0 = oct * 8, s0 = t0 & (SEQ - 1);
        REP(NREP_CONV)
#pragma unroll 1
        for (int g3 = 0; g3 < 4; ++g3) {
            unsigned xin[3][11]; float2 wv[3][4];
#pragma unroll
            for (int q = 0; q < 3; ++q) { const int c = (g3 * 3 + q) * 128 + 2 * lane;
#pragma unroll
                for (int j = 0; j < 4; ++j) wv[q][j] = *(const float2*)(P.conv_w + j * 1536 + c);
#pragma unroll
                for (int i = 0; i < 11; ++i) { const int s = s0 - 3 + i; xin[q][i] = (s >= 0) ? *(const unsigned*)(projb + (size_t)(t0 - 3 + i) * PROJ_LD + c) : 0u; } }
#pragma unroll
            for (int q = 0; q < 3; ++q) {
                const int g = g3 * 3 + q, c = g * 128 + 2 * lane;
                unsigned short tp0[8], tp1[8];
#pragma unroll
                for (int i = 0; i < 8; ++i) {
                    float y0 = 0.f, y1 = 0.f;
#pragma unroll
                    for (int j = 0; j < 4; ++j) { y0 += wv[q][j].x * bflo(xin[q][i + j]); y1 += wv[q][j].y * bfhi(xin[q][i + j]); }
                    y0 = siluf_(y0); y1 = siluf_(y1);
                    if (g < 8) {
                        const float ss = wave_sum(y0 * y0 + y1 * y1);
                        float sc = rsqrtf(ss + 1e-6f); if (g < 4) sc *= 0.08838834764831845f;
                        y0 *= sc; y1 *= sc;
                        *(unsigned*)(qk + (size_t)(t0 + i) * 1024 + c) = pack2(y0, y1);
                    }
                    tp0[i] = f2bf(y0); tp1[i] = f2bf(y1);
                }
                if (g >= 4) {
                    u32x4 w0, w1; w0.x = tp0[0] | ((unsigned)tp0[1] << 16); w0.y = tp0[2] | ((unsigned)tp0[3] << 16); w0.z = tp0[4] | ((unsigned)tp0[5] << 16); w0.w = tp0[6] | ((unsigned)tp0[7] << 16);
                    w1.x = tp1[0] | ((unsigned)tp1[1] << 16); w1.y = tp1[2] | ((unsigned)tp1[3] << 16); w1.z = tp1[4] | ((unsigned)tp1[5] << 16); w1.w = tp1[6] | ((unsigned)tp1[7] << 16);
                    bf16_t* sp = (bf16_t*)shm + ((size_t)((g - 4) * 128 + 2 * lane) * 72 + wid * 8);
                    *(u32x4*)sp = w0; *(u32x4*)(sp + 72) = w1;
                }
            }
        }
        __syncthreads();
        {
            const int cb = t0 >> 11, cn = (t0 & (SEQ - 1)) >> 6;
#pragma unroll 4
            for (int i = 0; i < 16; ++i) {
                const int idx = i * 512 + tid, row = idx >> 3, piece = idx & 7, gg = row >> 7, ch = row & 127;
                const u32x4 v = *(const u32x4*)((const bf16_t*)shm + (size_t)row * 72 + piece * 8);
                bf16_t* dst = (gg < 4 ? kT : vT) + ((size_t)((cb * 4 + (gg & 3)) * 32 + cn) * 128 + ch) * 64 + piece * 8;
                *(u32x4*)dst = v;
            }
        }
        __syncthreads();
        const int jf = lane & 7, sub = lane & 7;
        const float dtb = P.dt_bias[lane & 3], nal = -expf(P.a_log[lane & 3]);
#pragma unroll 1
        for (int tb4 = 0; tb4 < 8; tb4 += 4) {
        int posi[4]; u32x4 rq[4], rk[4]; float sa[4], sb[4], skv[4], swv[4]; f32x4 sqv[4];
#pragma unroll
        for (int i = 0; i < 4; ++i) {
            const int tok = t0 + tb4 + i; const float* sd = side + (size_t)tok * SIDE_LD; const bf16_t* pr = projb + (size_t)tok * PROJ_LD;
            posi[i] = P.pos[tok]; rq[i] = *(const u32x4*)(pr + 2048 + lane * 8); rk[i] = *(const u32x4*)(pr + 2560 + sub * 8);
            sb[i] = sd[68 + (lane & 3)]; sa[i] = sd[72 + (lane & 3)]; skv[i] = sd[lane]; swv[i] = sd[64 + (lane & 3)]; sqv[i] = *(const f32x4*)(sd + 128 + lane * 4);
        }
#pragma unroll
        for (int i = 0; i < 4; ++i) {
            const int tok = t0 + tb4 + i; const float pos = (float)posi[i];
            float* sd = side + (size_t)tok * SIDE_LD; bf16_t* pr = projb + (size_t)tok * PROJ_LD;
            const float ang = pos * c_inv_freq[jf]; const float cs = cosf(ang), sn = sinf(ang);
            if (lane < 4) {
                const float xa = sa[i] + dtb; const float sp = xa > 20.f ? xa : log1pf(expf(xa));
                bg[(size_t)tok * 8 + lane] = 1.0f / (1.0f + expf(-sb[i])); bg[(size_t)tok * 8 + 4 + lane] = nal * sp;
            }
#pragma unroll
            for (int pass = 0; pass < 2; ++pass) {
                bf16_t* ptr = pass == 0 ? pr + 2048 + lane * 8 : pr + 2560 + sub * 8;
                const u32x4 raw = pass == 0 ? rq[i] : rk[i]; f32x4 a, b; unpack8(raw, a, b);
                float y[8] = {a[0], a[1], a[2], a[3], b[0], b[1], b[2], b[3]};
                float ss = 0.f;
#pragma unroll
                for (int d = 0; d < 8; ++d) ss += y[d] * y[d];
                ss += __shfl_xor(ss, 1); ss += __shfl_xor(ss, 2); ss += __shfl_xor(ss, 4);
                const float rstd = rsqrtf(ss * (1.0f / 64.0f) + 1e-6f); const float* gn = (pass == 0 ? P.q_norm : P.k_norm) + sub * 8;
#pragma unroll
                for (int d = 0; d < 8; ++d) y[d] = y[d] * rstd * gn[d];
                float o[8];
#pragma unroll
                for (int d = 0; d < 8; ++d) {
                    const float other = __shfl_xor(y[d], 1); const float c_ = __shfl(cs, d), s_ = __shfl(sn, d);
                    o[d] = sub == 0 ? y[d] * c_ - other * s_ : (sub == 1 ? y[d] * c_ + other * s_ : y[d]);
                }
                const float scl = pass == 0 ? 0.18033688011112042f : 1.0f;
                f32x4 oa = {o[0] * scl, o[1] * scl, o[2] * scl, o[3] * scl}, ob = {o[4] * scl, o[5] * scl, o[6] * scl, o[7] * scl};
                if (pass == 0 || lane < 8) *(u32x4*)ptr = pack8(oa, ob);
            }
            {
                const float kx_lo = __shfl(skv[i], lane & 7), kx_hi = __shfl(skv[i], 8 + (lane & 7));
                const float kr = lane < 8 ? kx_lo * cs - kx_hi * sn : (lane < 16 ? kx_hi * cs + kx_lo * sn : skv[i]);
                const float khi = bf2f(f2bf(kr)); bf16_t* kb = (bf16_t*)sd;
                const int sq = lane & 15; f32x4 qv = sqv[i]; f32x4 pv;
#pragma unroll
                for (int e = 0; e < 4; ++e) pv[e] = __shfl_xor(qv[e], 2);
#pragma unroll
                for (int e = 0; e < 4; ++e) { const int fj = (sq & 1) * 4 + e; const float c_ = __shfl(cs, fj), s_ = __shfl(sn, fj);
                    qv[e] = sq < 2 ? qv[e] * c_ - pv[e] * s_ : (sq < 4 ? qv[e] * c_ + pv[e] * s_ : qv[e]); }
                f32x4 qh; u32x2 whi = pack4(qv);
                qh[0] = bflo(whi.x); qh[1] = bfhi(whi.x); qh[2] = bflo(whi.y); qh[3] = bfhi(whi.y);
                bf16_t* qb_ = (bf16_t*)(sd + 128 + (lane >> 4) * 64);
                kb[lane] = f2bf(kr); kb[64 + lane] = f2bf(kr - khi);
                *(u32x2*)(qb_ + sq * 4) = whi; *(u32x2*)(qb_ + 64 + sq * 4) = pack4(qv - qh);
                if (lane >= 40 && lane < 44) sd[64 + (lane & 3)] = swv[i] * 0.0625f;
            }
        }
        }
    }
}

typedef short bf16x8 __attribute__((ext_vector_type(8)));
typedef short s16x4 __attribute__((ext_vector_type(4)));
#define MFMA16(a, b, c) __builtin_amdgcn_mfma_f32_16x16x32_bf16(a, b, c, 0, 0, 0)
__device__ __forceinline__ bf16x8 cat8(const s16x4 a, const s16x4 b) { return __builtin_shufflevector(a, b, 0, 1, 2, 3, 4, 5, 6, 7); }
__device__ __forceinline__ bf16x8 packf8(const f32x4& a, const f32x4& b) { const u32x4 w = pack8(a, b); return __builtin_bit_cast(bf16x8, w); }
constexpr size_t OFF_WNEG = 460 * MiB, OFF_INTRA = 492 * MiB, OFF_GCB = 508 * MiB;
__device__ __forceinline__ void dn_d1(const Params& P, int ch, float* lw  ) {
    unsigned char* ws = P.ws; const int lane = otid() & 63, lr = lane & 15, lq = lane >> 4;
    const bf16_t* qk = (const bf16_t*)(ws + OFF_R1); const float* bg = (const float*)(ws + OFF_BG);
    const bf16_t* vT = (const bf16_t*)((unsigned char*)P.out + 64 * MiB); const bf16_t* kT = (const bf16_t*)((unsigned char*)P.out + 96 * MiB);
    bf16_t* uT = (bf16_t*)P.out; bf16_t* wneg = (bf16_t*)(ws + OFF_WNEG); bf16_t* intra = (bf16_t*)(ws + OFF_INTRA); float* gcb = (float*)(ws + OFF_GCB);
    const int b = ch >> 7, h = (ch >> 5) & 3, n = ch & 31; const size_t tok0 = (size_t)b * SEQ + n * 64;
    const float beta = bg[(tok0 + lane) * 8 + h];
    float gc = bg[(tok0 + lane) * 8 + 4 + h];
#pragma unroll
    for (int o = 1; o < 64; o <<= 1) { const float t = __shfl_up(gc, o); if (lane >= o) gc += t; }
    const float glast = __shfl(gc, 63), egc = __expf(gc);
    gcb[(size_t)ch * 192 + lane] = egc; gcb[(size_t)ch * 192 + 64 + lane] = __expf(glast - gc); if (lane == 0) gcb[(size_t)ch * 192 + 128] = __expf(glast);
    bf16x8 kf[4][4], qf[4][4];
#pragma unroll
    for (int t = 0; t < 4; ++t)
#pragma unroll
        for (int ks = 0; ks < 4; ++ks) { const bf16_t* rp = qk + (tok0 + t * 16 + lr) * 1024 + h * 128 + ks * 32 + lq * 8; qf[t][ks] = *(const bf16x8*)rp; kf[t][ks] = *(const bf16x8*)(rp + 512); }
#pragma unroll
    for (int mt = 0; mt < 4; ++mt)
#pragma unroll
        for (int nt = 0; nt <= mt; ++nt) {
            f32x4 acc = {0.f, 0.f, 0.f, 0.f};
#pragma unroll
            for (int ks = 0; ks < 4; ++ks) acc = MFMA16(kf[mt][ks], kf[nt][ks], acc);
            const int e = nt * 16 + lr; const float gce = __shfl(gc, e);
#pragma unroll
            for (int j = 0; j < 4; ++j) { const int c = mt * 16 + lq * 4 + j; const float gcc = __shfl(gc, c), bc = __shfl(beta, c);
                lw[c * 64 + e] = (e < c) ? bc * acc[j] * __expf(gcc - gce) : 0.f; }
        }
#pragma unroll
    for (int et = 0; et < 4; ++et)
#pragma unroll
        for (int ct = 0; ct < 4; ++ct) {
            f32x4 val = {0.f, 0.f, 0.f, 0.f};
            if (et <= ct) {
                f32x4 acc = {0.f, 0.f, 0.f, 0.f};
#pragma unroll
                for (int ks = 0; ks < 4; ++ks) acc = MFMA16(kf[et][ks], qf[ct][ks], acc);
                const int c = ct * 16 + lr; const float gcc = __shfl(gc, c);
#pragma unroll
                for (int j = 0; j < 4; ++j) { const int e = et * 16 + lq * 4 + j; const float gce = __shfl(gc, e); val[j] = (e <= c) ? acc[j] * __expf(gcc - gce) : 0.f; }
            }
            *(u32x2*)(intra + ((size_t)ch * 64 + ct * 16 + lr) * 64 + et * 16 + lq * 4) = pack4(val);
        }
    float Tr[64];
    Tr[0] = lane == 0 ? 1.f : 0.f;
#pragma unroll
    for (int c = 1; c < 64; ++c) {
        __builtin_amdgcn_sched_barrier(0);
        int off = c * 64, lo = lane; asm volatile("" : "+v"(off), "+v"(lo) : "v"(Tr[c - 1]));
        float a0 = 0.f, a1 = 0.f;
#pragma unroll
        for (int e4 = 0; e4 * 4 < c; ++e4) {
            const f32x4 l = *(const f32x4*)(lw + off + e4 * 4);
            if (e4 * 4 + 0 < c) a0 += l[0] * Tr[e4 * 4 + 0];
            if (e4 * 4 + 1 < c) a1 += l[1] * Tr[e4 * 4 + 1];
            if (e4 * 4 + 2 < c) a0 += l[2] * Tr[e4 * 4 + 2];
            if (e4 * 4 + 3 < c) a1 += l[3] * Tr[e4 * 4 + 3];
        }
        Tr[c] = (lo == c ? 1.f : 0.f) - (a0 + a1);
    }
    __builtin_amdgcn_sched_barrier(0);
    bf16_t* Tu = (bf16_t*)lw; bf16_t* Tw = Tu + 4096;
    {
        int off = lane; asm volatile("" : "+v"(off) : "v"(Tr[63]));
        const float bw = beta * egc;
#pragma unroll
        for (int c = 0; c < 64; ++c) { Tu[c * 64 + off] = f2bf(Tr[c] * beta); Tw[c * 64 + off] = f2bf(Tr[c] * bw); }
    }
    __builtin_amdgcn_sched_barrier(0);
    {
        bf16x8 ta[4][2];
#pragma unroll
        for (int mt = 0; mt < 4; ++mt) { const int rt = (lr >> 2) * 16 + mt * 4 + (lr & 3); ta[mt][0] = *(const bf16x8*)(Tu + rt * 64 + lq * 8); ta[mt][1] = *(const bf16x8*)(Tu + rt * 64 + 32 + lq * 8); }
#pragma unroll
        for (int nt = 0; nt < 8; ++nt) {
            const bf16_t* vp = vT + ((size_t)ch * 128 + nt * 16 + lr) * 64 + lq * 8;
            const bf16x8 v0 = *(const bf16x8*)vp, v1 = *(const bf16x8*)(vp + 32);
            f32x4 acc[4];
#pragma unroll
            for (int mt = 0; mt < 4; ++mt) { acc[mt] = (f32x4){0.f, 0.f, 0.f, 0.f}; acc[mt] = MFMA16(ta[mt][0], v0, acc[mt]); acc[mt] = MFMA16(ta[mt][1], v1, acc[mt]); }
            bf16_t* up = uT + ((size_t)ch * 128 + nt * 16 + lr) * 64 + lq * 16;
            *(u32x4*)up = pack8(acc[0], acc[1]); *(u32x4*)(up + 8) = pack8(acc[2], acc[3]);
        }
    }
    {
        bf16x8 ka[8][2];
#pragma unroll
        for (int nt = 0; nt < 8; ++nt) { const int rd = (lr >> 2) * 32 + nt * 4 + (lr & 3); const bf16_t* kp = kT + ((size_t)ch * 128 + rd) * 64 + lq * 8; ka[nt][0] = *(const bf16x8*)kp; ka[nt][1] = *(const bf16x8*)(kp + 32); }
#pragma unroll
        for (int ct = 0; ct < 4; ++ct) {
            const bf16x8 b0 = *(const bf16x8*)(Tw + (ct * 16 + lr) * 64 + lq * 8), b1 = *(const bf16x8*)(Tw + (ct * 16 + lr) * 64 + 32 + lq * 8);
            f32x4 acc[8];
#pragma unroll
            for (int nt = 0; nt < 8; ++nt) { acc[nt] = (f32x4){0.f, 0.f, 0.f, 0.f}; acc[nt] = MFMA16(ka[nt][0], b0, acc[nt]); acc[nt] = MFMA16(ka[nt][1], b1, acc[nt]); }
            bf16_t* wp = wneg + ((size_t)ch * 64 + ct * 16 + lr) * 128 + lq * 32;
#pragma unroll
            for (int q = 0; q < 4; ++q) *(u32x4*)(wp + q * 8) = pack8(-acc[2 * q], -acc[2 * q + 1]);
        }
    }
}
#define LDS_BARRIER() do { asm volatile("s_waitcnt lgkmcnt(0)" ::: "memory"); __builtin_amdgcn_s_barrier(); asm volatile("" ::: "memory"); } while (0)
struct D2Ops { bf16x8 w[4], q[4], in[2], kt[2][2]; u32x2 u[2]; f32x4 egc, dec; float egl; };
__device__ __forceinline__ void d2_load(D2Ops& o, const bf16_t* qk, const bf16_t* kT, const bf16_t* uT, const bf16_t* wneg, const bf16_t* intra, const float* gcb, int b, int h, int dv0, int n, int j, int lr, int lq) {
    const int ch = (b * 4 + h) * 32 + n; const size_t tok0 = (size_t)b * SEQ + n * 64; const float* gp = gcb + (size_t)ch * 192;
    const int kk = j >> 1, d = j & 1, trow = 32 * kk + (lr >> 2) * 8 + d * 4 + (lr & 3), tcol = 32 * kk + lq * 8 + d * 4;
    o.egl = gp[128]; o.egc = *(const f32x4*)(gp + tcol); o.dec = *(const f32x4*)(gp + 64 + tcol);
#pragma unroll
    for (int sl = 0; sl < 2; ++sl) o.u[sl] = *(const u32x2*)(uT + ((size_t)ch * 128 + dv0 + sl * 16 + lr) * 64 + tcol);
    const bf16_t* wp = wneg + ((size_t)ch * 64 + trow) * 128 + lq * 8; const bf16_t* qp = qk + (tok0 + trow) * 1024 + h * 128 + lq * 8;
#pragma unroll
    for (int ks = 0; ks < 4; ++ks) { o.w[ks] = *(const bf16x8*)(wp + ks * 32); o.q[ks] = *(const bf16x8*)(qp + ks * 32); }
    const bf16_t* ip = intra + ((size_t)ch * 64 + trow) * 64 + lq * 8;
#pragma unroll
    for (int k2 = 0; k2 < 2; ++k2) o.in[k2] = *(const bf16x8*)(ip + k2 * 32);
#pragma unroll
    for (int dd = 0; dd < 2; ++dd) { const int dkr = 32 * j + (lr >> 2) * 8 + dd * 4 + (lr & 3); const bf16_t* kp = kT + ((size_t)ch * 128 + dkr) * 64 + lq * 8;
#pragma unroll
        for (int k2 = 0; k2 < 2; ++k2) o.kt[dd][k2] = *(const bf16x8*)(kp + k2 * 32); }
}
__device__ __forceinline__ void dn_d2(const Params& P, unsigned char* shm) {
    unsigned char* ws = P.ws; const int tid = otid(), lane = tid & 63, wid = tid >> 6, lr = lane & 15, lq = lane >> 4, j = wid & 3, ul = wid >> 2;
    const bf16_t* qk = (const bf16_t*)(ws + OFF_R1); const bf16_t* kT = (const bf16_t*)((unsigned char*)P.out + 96 * MiB);
    const bf16_t* uT = (const bf16_t*)P.out; const bf16_t* wneg = (const bf16_t*)(ws + OFF_WNEG); const bf16_t* intra = (const bf16_t*)(ws + OFF_INTRA); const float* gcb = (const float*)(ws + OFF_GCB);
    bf16_t* odn = (bf16_t*)(ws + OFF_PROJ);
    const int xcd = blockIdx.x & 7, tq = blockIdx.x >> 3, grp = (tq >> 1) * 8 + xcd;
    const int b = grp >> 2, h = grp & 3, dv0 = ((tq & 1) * 2 + ul) * 32;
    unsigned char* ub = shm + ul * 24576; unsigned char* sbp = ub; unsigned char* vbp = ub + 16384; unsigned char* vdp = ub + 20480;
    f32x4 S0[2], S1[2];
#pragma unroll
    for (int sl = 0; sl < 2; ++sl) { S0[sl] = (f32x4){0.f, 0.f, 0.f, 0.f}; S1[sl] = (f32x4){0.f, 0.f, 0.f, 0.f}; *(u32x4*)(sbp + (size_t)(((0 * 4 + j) * 2 + sl) * 64 + lane) * 16) = (u32x4){0u, 0u, 0u, 0u}; }
    auto step = [&](const D2Ops& cur, int n) {
        const int buf = n & 1; const size_t tok0 = (size_t)b * SEQ + n * 64; const int kk = j >> 1, d = j & 1;
        LDS_BARRIER();
        bf16x8 Sb[4][2];
#pragma unroll
        for (int ks = 0; ks < 4; ++ks)
#pragma unroll
            for (int sl = 0; sl < 2; ++sl) Sb[ks][sl] = *(const bf16x8*)(sbp + (size_t)(((buf * 4 + ks) * 2 + sl) * 64 + lane) * 16);
#pragma unroll
        for (int sl = 0; sl < 2; ++sl) {
            f32x4 vn = {bflo(cur.u[sl].x), bfhi(cur.u[sl].x), bflo(cur.u[sl].y), bfhi(cur.u[sl].y)};
#pragma unroll
            for (int ks = 0; ks < 4; ++ks) vn = MFMA16(cur.w[ks], Sb[ks][sl], vn);
            *(u32x2*)(vbp + (size_t)((kk * 2 + sl) * 64 + lane) * 16 + d * 8) = pack4(vn);
            *(u32x2*)(vdp + (size_t)((kk * 2 + sl) * 64 + lane) * 16 + d * 8) = pack4(vn * cur.dec);
        }
        LDS_BARRIER();
#pragma unroll
        for (int sl = 0; sl < 2; ++sl) {
            bf16x8 Vb[2], Vd[2];
#pragma unroll
            for (int k2 = 0; k2 < 2; ++k2) { Vb[k2] = *(const bf16x8*)(vbp + (size_t)((k2 * 2 + sl) * 64 + lane) * 16); Vd[k2] = *(const bf16x8*)(vdp + (size_t)((k2 * 2 + sl) * 64 + lane) * 16); }
            f32x4 acc = {0.f, 0.f, 0.f, 0.f};
#pragma unroll
            for (int ks = 0; ks < 4; ++ks) acc = MFMA16(cur.q[ks], Sb[ks][sl], acc);
            acc *= cur.egc;
#pragma unroll
            for (int k2 = 0; k2 < 2; ++k2) acc = MFMA16(cur.in[k2], Vb[k2], acc);
#pragma unroll
            for (int jj = 0; jj < 4; ++jj) odn[(tok0 + 32 * kk + lq * 8 + d * 4 + jj) * PROJ_LD + h * 128 + dv0 + sl * 16 + lr] = f2bf(acc[jj]);
            S0[sl] *= cur.egl; S1[sl] *= cur.egl;
#pragma unroll
            for (int k2 = 0; k2 < 2; ++k2) { S0[sl] = MFMA16(cur.kt[0][k2], Vd[k2], S0[sl]); S1[sl] = MFMA16(cur.kt[1][k2], Vd[k2], S1[sl]); }
            *(u32x4*)(sbp + (size_t)((((buf ^ 1) * 4 + j) * 2 + sl) * 64 + lane) * 16) = pack8(S0[sl], S1[sl]);
        }
    };
    D2Ops A, B; d2_load(A, qk, kT, uT, wneg, intra, gcb, b, h, dv0, 0, j, lr, lq);
#pragma unroll 1
    for (int n = 0; n < 32; n += 2) {
        d2_load(B, qk, kT, uT, wneg, intra, gcb, b, h, dv0, n + 1, j, lr, lq);
        step(A, n);
        d2_load(A, qk, kT, uT, wneg, intra, gcb, b, h, dv0, n + 2 < 32 ? n + 2 : 31, j, lr, lq);
        step(B, n + 1);
    }
    __syncthreads();
}
__device__ __forceinline__ unsigned okey(float f) { const unsigned u = __float_as_uint(f); return (u & 0x80000000u) ? ~u : (u | 0x80000000u); }
constexpr int SA_LW = 3072;
__device__ void sa_naive_query(const Params& P, int tok, float* lw) {
    unsigned char* ws = P.ws; const int lane = otid() & 63;
    const bf16_t* projb = (const bf16_t*)(ws + OFF_PROJ); const float* side = (const float*)(ws + OFF_SIDE);
    bf16_t* ob = (bf16_t*)((unsigned char*)P.out + 32 * MiB);
    const int b = tok >> 11, pos = tok & (SEQ - 1), n = pos + 1; const size_t tb = (size_t)b * SEQ;
    float* sc = lw; float* ql = lw + 2048; float* qil = lw + 2560; int* idx = (int*)(lw + 2816);
    { const u32x4 raw = *(const u32x4*)(projb + (size_t)tok * PROJ_LD + 2048 + lane * 8); f32x4 a, c; unpack8(raw, a, c); *(f32x4*)(ql + lane * 8) = a; *(f32x4*)(ql + lane * 8 + 4) = c;
      *(f32x4*)(qil + lane * 4) = *(const f32x4*)(side + (size_t)tok * SIDE_LD + 128 + lane * 4); }
    int cnt;
    if (n <= 256) {
#pragma unroll
        for (int i = 0; i < 4; ++i) idx[i * 64 + lane] = i * 64 + lane;
        cnt = n;
    } else {
        const float w0 = side[(size_t)tok * SIDE_LD + 64], w1 = side[(size_t)tok * SIDE_LD + 65], w2 = side[(size_t)tok * SIDE_LD + 66], w3 = side[(size_t)tok * SIDE_LD + 67];
#pragma unroll 1
        for (int i = 0; i * 64 < n; ++i) {
            const int key = i * 64 + lane; const int kc = key < n ? key : pos;
            const f32x4* kr = (const f32x4*)(side + (tb + kc) * SIDE_LD);
            float s0 = 0.f, s1 = 0.f, s2 = 0.f, s3 = 0.f;
#pragma unroll 4
            for (int dq = 0; dq < 16; ++dq) {
                asm volatile("" ::: "memory");
                const f32x4 kv = kr[dq]; const f32x4 q0 = ((const f32x4*)qil)[dq], q1 = ((const f32x4*)qil)[16 + dq], q2 = ((const f32x4*)qil)[32 + dq], q3 = ((const f32x4*)qil)[48 + dq];
                s0 += kv[0] * q0[0] + kv[1] * q0[1] + kv[2] * q0[2] + kv[3] * q0[3]; s1 += kv[0] * q1[0] + kv[1] * q1[1] + kv[2] * q1[2] + kv[3] * q1[3];
                s2 += kv[0] * q2[0] + kv[1] * q2[1] + kv[2] * q2[2] + kv[3] * q2[3]; s3 += kv[0] * q3[0] + kv[1] * q3[1] + kv[2] * q3[2] + kv[3] * q3[3];
            }
            float s = fmaxf(s0, 0.f) * w0; s = fmaf(fmaxf(s1, 0.f), w1, s); s = fmaf(fmaxf(s2, 0.f), w2, s); s = fmaf(fmaxf(s3, 0.f), w3, s); s += 0.0f;
            sc[key] = s;
        }
        unsigned a[32];
#pragma unroll
        for (int i = 0; i < 32; ++i) { const int key = i * 64 + lane; a[i] = key < n ? okey(sc[key < n ? key : 0]) : 0u; }
        unsigned Tm = 0;
#pragma unroll 1
        for (int bit = 31; bit >= 0; --bit) {
            const unsigned cand = Tm | (1u << bit); int c = 0;
#pragma unroll
            for (int i = 0; i < 32; ++i) c += __popcll(__ballot(a[i] >= cand));
            if (c >= 256) Tm = cand;
        }
        int cgt = 0;
#pragma unroll
        for (int i = 0; i < 32; ++i) cgt += __popcll(__ballot(a[i] > Tm));
        int rem = 256 - cgt, base = 0; const u64 lt = (1ull << lane) - 1ull;
#pragma unroll
        for (int i = 0; i < 32; ++i) {
            const u64 eq = __ballot(a[i] == Tm); const int rk = __popcll(eq & lt);
            const bool sel = (a[i] > Tm) || (a[i] == Tm && rk < rem);
            const u64 sm = __ballot(sel);
            if (sel) idx[base + __popcll(sm & lt)] = i * 64 + lane;
            base += __popcll(sm); const int ne = __popcll(eq); rem -= ne < rem ? ne : rem;
        }
        cnt = base;
    }
    float* Pm = sc; float ls[8];
#pragma unroll
    for (int h = 0; h < 8; ++h) ls[h] = 0.f;
#pragma unroll 1
    for (int r = 0; r < 4; ++r) {
        const int kk = r * 64 + lane; const bool ok = kk < cnt; const int key = ok ? idx[kk] : 0;
        const u32x4* kr = (const u32x4*)(projb + (tb + key) * PROJ_LD + 2560);
        float lg[8];
#pragma unroll
        for (int h = 0; h < 8; ++h) lg[h] = 0.f;
        u32x4 nxt = kr[0];
#pragma unroll 1
        for (int j = 0; j < 8; ++j) {
            const u32x4 cur = nxt; if (j < 7) nxt = kr[j + 1];
            f32x4 x, y; unpack8(cur, x, y);
            const f32x4* qp = (const f32x4*)ql + 2 * j;
#pragma unroll
            for (int h = 0; h < 8; ++h) { const f32x4 qa = qp[h * 16], qb = qp[h * 16 + 1];
                lg[h] += (x[0] * qa[0] + x[1] * qa[1]) + (x[2] * qa[2] + x[3] * qa[3]) + (y[0] * qb[0] + y[1] * qb[1]) + (y[2] * qb[2] + y[3] * qb[3]); }
        }
        float pv[8];
#pragma unroll
        for (int h = 0; h < 8; ++h) { const float p = ok ? __expf(lg[h] - 8.0f) : 0.f; pv[h] = p; ls[h] += p; }
        *(f32x4*)(Pm + kk * 8) = (f32x4){pv[0], pv[1], pv[2], pv[3]}; *(f32x4*)(Pm + kk * 8 + 4) = (f32x4){pv[4], pv[5], pv[6], pv[7]};
    }
#pragma unroll
    for (int h = 0; h < 8; ++h) ls[h] = wave_sum(ls[h]);
    float o[8];
#pragma unroll
    for (int h = 0; h < 8; ++h) o[h] = 0.f;
    const bf16_t* vb = projb + tb * PROJ_LD + 2624 + lane;
#pragma unroll 1
    for (int k0 = 0; k0 < cnt; k0 += 8) {
        float vv[8];
#pragma unroll
        for (int j = 0; j < 8; ++j) { const int kk = k0 + j; const int key = idx[kk < cnt ? kk : 0]; vv[j] = kk < cnt ? bf2f(vb[(size_t)key * PROJ_LD]) : 0.f; }
#pragma unroll
        for (int j = 0; j < 8; ++j) { const f32x4 p0 = *(const f32x4*)(Pm + (k0 + j) * 8), p1 = *(const f32x4*)(Pm + (k0 + j) * 8 + 4);
            o[0] += p0[0] * vv[j]; o[1] += p0[1] * vv[j]; o[2] += p0[2] * vv[j]; o[3] += p0[3] * vv[j]; o[4] += p1[0] * vv[j]; o[5] += p1[1] * vv[j]; o[6] += p1[2] * vv[j]; o[7] += p1[3] * vv[j]; }
    }
#pragma unroll
    for (int h = 0; h < 8; ++h) ob[(size_t)tok * 512 + h * 64 + lane] = f2bf(o[h] / ls[h]);
}

__device__ __forceinline__ void phase_gnorm(const Params& P, int item) {
    unsigned char* ws = P.ws; const bf16_t* projb = (const bf16_t*)(ws + OFF_PROJ); bf16_t* oa = (bf16_t*)P.out;
    const int tid = otid(), lane = tid & 63, wid = tid >> 6;
    f32x4 g0 = *(const f32x4*)(P.dn_norm + (lane & 15) * 8), g1 = *(const f32x4*)(P.dn_norm + (lane & 15) * 8 + 4);
#pragma unroll 4
    for (int i = 0; i < 16; ++i) {
        const int tok = item * 128 + wid * 16 + i;
        f32x4 a, b, za, zb; unpack8(*(const u32x4*)(projb + (size_t)tok * PROJ_LD + lane * 8), a, b); unpack8(*(const u32x4*)(projb + (size_t)tok * PROJ_LD + 1536 + lane * 8), za, zb);
        float ss = a[0] * a[0] + a[1] * a[1] + a[2] * a[2] + a[3] * a[3] + b[0] * b[0] + b[1] * b[1] + b[2] * b[2] + b[3] * b[3];
        ss += __shfl_xor(ss, 1); ss += __shfl_xor(ss, 2); ss += __shfl_xor(ss, 4); ss += __shfl_xor(ss, 8);
        const float rstd = rsqrtf(ss * (1.0f / 128.0f) + 1e-6f);
#pragma unroll
        for (int j = 0; j < 4; ++j) { a[j] = a[j] * rstd * g0[j] * siluf_(za[j]); b[j] = b[j] * rstd * g1[j] * siluf_(zb[j]); }
        *(u32x4*)(oa + (size_t)tok * 512 + lane * 8) = pack8(a, b);
    }
}
__device__ __forceinline__ void split8(const f32x4& a, const f32x4& b, bf16x8& hi, bf16x8& lo) {
    const u32x4 w = pack8(a, b); f32x4 ha, hb; unpack8(w, ha, hb); hi = __builtin_bit_cast(bf16x8, w); lo = packf8(a - ha, b - hb);
}
#ifndef NREP_E1S
#define NREP_E1S 1
#endif
#ifndef NREP_SEL
#define NREP_SEL 1
#endif
#ifndef NREP_E2
#define NREP_E2 1
#endif
#ifndef REP
#define REP(n) _Pragma("unroll 1") for (int rep_ = 0; rep_ < (n); ++rep_)
#endif
template <int R> __device__ __forceinline__ void sa_select(const float* srow, int n, u64* mrow, int lane) {
    unsigned a[R];
#pragma unroll
    for (int i = 0; i < R; ++i) { const int key = i * 64 + lane; a[i] = key < n ? okey(srow[key < n ? key : 0]) : 0u; }
    unsigned Tm = 0; bool exact = false;
#pragma unroll 1
    for (int bit = 31; bit >= 0; --bit) {
        const unsigned cand = Tm | (1u << bit); int c = 0;
#pragma unroll
        for (int i = 0; i < R; ++i) c += __popcll(__ballot(a[i] >= cand));
        if (c >= 256) Tm = cand;
        if (c == 256) { exact = true; break; }
    }
    int rem = 1 << 30;
    if (!exact) {
        int cgt = 0;
#pragma unroll
        for (int i = 0; i < R; ++i) cgt += __popcll(__ballot(a[i] > Tm));
        rem = 256 - cgt;
    }
    const u64 lt = (1ull << lane) - 1ull;
#pragma unroll
    for (int i = 0; i < R; ++i) {
        const u64 eq = __ballot(a[i] == Tm); const int rk = __popcll(eq & lt);
        const bool sel = (a[i] > Tm) || (a[i] == Tm && rk < rem);
        const u64 sm = __ballot(sel);
        if (lane == 0) mrow[i * 64] = sm;
        const int ne = __popcll(eq); rem -= ne < rem ? ne : rem;
    }
    if (lane == 0) { for (int i = R; i < 32; ++i) mrow[i * 64] = 0ull; }
}
constexpr int KV_LD = 72;
__device__ __forceinline__ void sa_block(const Params& P, int b, int qb, unsigned char* shm) {
    unsigned char* ws = P.ws; const int tid = otid(), lane = tid & 63, wid = tid >> 6, lr = lane & 15, lq = lane >> 4;
    const bf16_t* projb = (const bf16_t*)(ws + OFF_PROJ); const float* side = (const float*)(ws + OFF_SIDE);
    bf16_t* ob = (bf16_t*)((unsigned char*)P.out + 32 * MiB);
    float* Sc = (float*)shm; u64* Mk = (u64*)(shm + LDS_MASK);
    const size_t tb = (size_t)b * SEQ; const int pos_blk = qb * 64;
#pragma unroll 1
    for (int sub = 0; sub < 4; ++sub) {
        const int pos0 = pos_blk + sub * 16; const size_t q0 = tb + pos0; const int ntile = pos0 / 16 + 1;
        REP(NREP_E1S) if (pos0 + 16 > 256) {
            bf16x8 Ah[4][2], Al[4][2]; f32x4 wq[4];
#pragma unroll
            for (int mt = 0; mt < 4; ++mt) {
                wq[mt] = *(const f32x4*)(side + (q0 + mt * 4 + lq) * SIDE_LD + 64);
#pragma unroll
                for (int ks = 0; ks < 2; ++ks) { const bf16_t* p = (const bf16_t*)(side + (q0 + mt * 4 + (lr >> 2)) * SIDE_LD + 128 + (lr & 3) * 64) + ks * 32 + lq * 8; Ah[mt][ks] = *(const bf16x8*)p; Al[mt][ks] = *(const bf16x8*)(p + 64); }
            }
            auto ldk = [&](int kt, f32x4 (&r)[4]) { const f32x4* kp = (const f32x4*)((const bf16_t*)(side + (tb + kt * 16 + lr) * SIDE_LD) + lq * 8); r[0] = kp[0]; r[1] = kp[4]; r[2] = kp[8]; r[3] = kp[12]; };
            auto score_tile = [&](int kt, const f32x4 (&r)[4]) {
                const bf16x8 Bh[2] = {__builtin_bit_cast(bf16x8, r[0]), __builtin_bit_cast(bf16x8, r[1])}, Bl[2] = {__builtin_bit_cast(bf16x8, r[2]), __builtin_bit_cast(bf16x8, r[3])};
                const int key = kt * 16 + lr;
#pragma unroll
                for (int mt = 0; mt < 4; ++mt) {
                    f32x4 acc = {0.f, 0.f, 0.f, 0.f};
#pragma unroll
                    for (int ks = 0; ks < 2; ++ks) { acc = MFMA16(Al[mt][ks], Bh[ks], acc); acc = MFMA16(Ah[mt][ks], Bl[ks], acc); }
#pragma unroll
                    for (int ks = 0; ks < 2; ++ks) acc = MFMA16(Ah[mt][ks], Bh[ks], acc);
                    float s = fmaxf(acc[0], 0.f) * wq[mt][0]; s = fmaf(fmaxf(acc[1], 0.f), wq[mt][1], s); s = fmaf(fmaxf(acc[2], 0.f), wq[mt][2], s); s = fmaf(fmaxf(acc[3], 0.f), wq[mt][3], s); s += 0.0f;
                    Sc[(mt * 4 + lq) * SC_LD + key] = s;
                }
            };
            f32x4 r0[4], r1[4], r2[4], r3[4], r4[4], r5[4];
            if (wid < ntile) ldk(wid, r0); if (wid + 8 < ntile) ldk(wid + 8, r1);
            if (wid + 16 < ntile) ldk(wid + 16, r2); if (wid + 24 < ntile) ldk(wid + 24, r3);
#pragma unroll 1
            for (int kt = wid; kt < ntile; kt += 48) {
                if (kt + 32 < ntile) ldk(kt + 32, r4); if (kt + 40 < ntile) ldk(kt + 40, r5);
                score_tile(kt, r0); if (kt + 8 < ntile) score_tile(kt + 8, r1);
                if (kt + 48 < ntile) ldk(kt + 48, r0); if (kt + 56 < ntile) ldk(kt + 56, r1);
                if (kt + 16 < ntile) score_tile(kt + 16, r2); if (kt + 24 < ntile) score_tile(kt + 24, r3);
                if (kt + 64 < ntile) ldk(kt + 64, r2); if (kt + 72 < ntile) ldk(kt + 72, r3);
                if (kt + 32 < ntile) score_tile(kt + 32, r4); if (kt + 40 < ntile) score_tile(kt + 40, r5);
            }
        }
        __syncthreads();
        REP(NREP_SEL)
#pragma unroll 1
        for (int qq = 0; qq < 2; ++qq) {
            const int ql = wid * 2 + qq, n = pos0 + ql + 1; u64* mrow = Mk + (sub * 16 + ql); const float* srow = Sc + ql * SC_LD;
            if (n <= 256) { if (lane < 32) { const int k0 = lane * 64; mrow[lane * 64] = n >= k0 + 64 ? ~0ull : (n > k0 ? ((1ull << (n - k0)) - 1ull) : 0ull); } }
            else if (n <= 512) sa_select<8>(srow, n, mrow, lane);
            else if (n <= 1024) sa_select<16>(srow, n, mrow, lane);
            else if (n <= 1536) sa_select<24>(srow, n, mrow, lane);
            else sa_select<32>(srow, n, mrow, lane);
        }
        __syncthreads();
    }
    REP(NREP_E2) {
    bf16_t* Kl = (bf16_t*)shm; bf16_t* Vl = Kl + 64 * KV_LD;
    const size_t t0 = tb + pos_blk;
    bf16x8 Qb[4][2];
#pragma unroll
    for (int nt = 0; nt < 4; ++nt)
#pragma unroll
        for (int ks = 0; ks < 2; ++ks) Qb[nt][ks] = *(const bf16x8*)(projb + (t0 + nt * 16 + lr) * PROJ_LD + 2048 + wid * 64 + ks * 32 + lq * 8);
    f32x4 O[4][4], Ls[4]; const short one_bf = lr == 0 ? (short)0x3F80 : (short)0; const bf16x8 ones = {one_bf, one_bf, one_bf, one_bf, one_bf, one_bf, one_bf, one_bf};
#pragma unroll
    for (int md = 0; md < 4; ++md)
#pragma unroll
        for (int nt = 0; nt < 4; ++nt) O[md][nt] = (f32x4){0.f, 0.f, 0.f, 0.f};
#pragma unroll
    for (int nt = 0; nt < 4; ++nt) Ls[nt] = (f32x4){0.f, 0.f, 0.f, 0.f};
    const int skey = tid >> 3, sch = tid & 7;
    u32x4 kreg = *(const u32x4*)(projb + (tb + skey) * PROJ_LD + 2560 + sch * 8), vreg = *(const u32x4*)(projb + (tb + skey) * PROJ_LD + 2624 + sch * 8);
#pragma unroll 1
    for (int kt = 0; kt <= qb; ++kt) {
        LDS_BARRIER();
        *(u32x4*)(Kl + skey * KV_LD + sch * 8) = kreg;
        { const unsigned vv[4] = {vreg.x, vreg.y, vreg.z, vreg.w};
#pragma unroll
          for (int x = 0; x < 4; ++x) { Vl[(sch * 8 + 2 * x) * KV_LD + skey] = (bf16_t)(vv[x] & 0xFFFFu); Vl[(sch * 8 + 2 * x + 1) * KV_LD + skey] = (bf16_t)(vv[x] >> 16); } }
        LDS_BARRIER();
        if (kt < qb) { const size_t kr = tb + (size_t)(kt + 1) * 64 + skey; kreg = *(const u32x4*)(projb + kr * PROJ_LD + 2560 + sch * 8); vreg = *(const u32x4*)(projb + kr * PROJ_LD + 2624 + sch * 8); }
        bf16x8 Kf[4][2], Vf[4][2];
#pragma unroll
        for (int m = 0; m < 4; ++m)
#pragma unroll
            for (int k2 = 0; k2 < 2; ++k2) {
                Kf[m][k2] = *(const bf16x8*)(Kl + (m * 16 + lr) * KV_LD + k2 * 32 + lq * 8);
                Vf[m][k2] = cat8(*(const s16x4*)(Vl + (m * 16 + lr) * KV_LD + k2 * 32 + lq * 4), *(const s16x4*)(Vl + (m * 16 + lr) * KV_LD + k2 * 32 + 16 + lq * 4));
            }
#pragma unroll
        for (int nt = 0; nt < 4; ++nt) {
            const u64 mw = Mk[kt * 64 + nt * 16 + lr];
            f32x4 pt[4];
#pragma unroll
            for (int mk = 0; mk < 4; ++mk) {
                f32x4 acc = {-11.541560327111707f, -11.541560327111707f, -11.541560327111707f, -11.541560327111707f};
                acc = MFMA16(Kf[mk][0], Qb[nt][0], acc); acc = MFMA16(Kf[mk][1], Qb[nt][1], acc);
                const int bits = (int)(unsigned)(mw >> (mk * 16 + lq * 4));
#pragma unroll
                for (int j = 0; j < 4; ++j) pt[mk][j] = __uint_as_float(__float_as_uint(__builtin_amdgcn_exp2f(acc[j])) & (unsigned)__builtin_amdgcn_sbfe(bits, j, 1));
            }
            const bf16x8 P0 = packf8(pt[0], pt[1]), P1 = packf8(pt[2], pt[3]);
#pragma unroll
            for (int md = 0; md < 4; ++md) { O[md][nt] = MFMA16(Vf[md][0], P0, O[md][nt]); O[md][nt] = MFMA16(Vf[md][1], P1, O[md][nt]); }
            Ls[nt] = MFMA16(ones, P0, Ls[nt]); Ls[nt] = MFMA16(ones, P1, Ls[nt]);
        }
    }
#pragma unroll
    for (int nt = 0; nt < 4; ++nt) {
        const float l = __shfl(Ls[nt][0], lr); const float inv = __builtin_amdgcn_rcpf(l);
#pragma unroll
        for (int md = 0; md < 4; ++md) *(u32x2*)(ob + (t0 + nt * 16 + lr) * 512 + wid * 64 + md * 16 + lq * 4) = pack4(O[md][nt] * inv);
    }
    __syncthreads();
    }
}
#define XB_TMO      128
#define XB_XCNT(j)  (256  + 64 * (j))
#define XB_XSUB(j)  (1280 + 64 * (j))
#define XB_XGEN(j)  (2304 + 64 * (j))
#define XB_TOP      3328
#define XB_TOPGEN   3392
#define XCD_BAR_WORDS 3456
#define XB_SPIN_CAP (1u << 18)
#define LAS __attribute__((address_space(3)))

__device__ __forceinline__ unsigned xb_ld(unsigned* p)              { return __hip_atomic_load(p, __ATOMIC_RELAXED, __HIP_MEMORY_SCOPE_AGENT); }
__device__ __forceinline__ unsigned xb_add(unsigned* p, unsigned v) { return __hip_atomic_fetch_add(p, v, __ATOMIC_RELAXED, __HIP_MEMORY_SCOPE_AGENT); }
__device__ __forceinline__ unsigned xb_xcc_id() { return (unsigned)__builtin_amdgcn_s_getreg((3 << 11) | 20) & 0xFu; }
#define XB_SPIN(cond, bar) do { unsigned _sp = 0; while (cond) { __builtin_amdgcn_s_sleep(1); \
    if ((++_sp & 255u) == 0u) { if (xb_ld(&(bar)[XB_TMO])) break; if (_sp > XB_SPIN_CAP) { atomicAdd(&(bar)[XB_TMO], 1u); break; } } } } while (0)

struct XcdBarrier {
    unsigned* bar; unsigned x;
    volatile LAS unsigned* st;
};

__device__ __forceinline__ XcdBarrier xcd_barrier_post(unsigned* bar, volatile LAS unsigned* st) {
    XcdBarrier b; b.bar = bar; b.x = xb_xcc_id(); b.st = st;
    if (threadIdx.x == 0) (void)xb_add(&bar[XB_XCNT(b.x)], 1u);
    return b;
}
__device__ __forceinline__ void xcd_barrier_complete(unsigned* bar, unsigned x, unsigned& nloc, unsigned& nx) {
    const unsigned G = gridDim.x * gridDim.y * gridDim.z;
    unsigned sum, cnt, mine, sp = 0u;
    for (;;) {
        sum = 0u; cnt = 0u; mine = 0u;
#pragma unroll
        for (unsigned j = 0; j < 16; ++j) { const unsigned c = xb_ld(&bar[XB_XCNT(j)]); sum += c; cnt += (c > 0u) ? 1u : 0u; mine = (j == x) ? c : mine; }
        if (sum == G) break;
        __builtin_amdgcn_s_sleep(1);
        if ((++sp & 255u) == 0u) { if (xb_ld(&bar[XB_TMO])) break; if (sp > XB_SPIN_CAP) { atomicAdd(&bar[XB_TMO], 1u); break; } }
    }
    nloc = mine > 0u ? mine : 1u; nx = cnt > 0u ? cnt : 1u;
}

__device__ __forceinline__ void xcd_barrier(const XcdBarrier& b) {
    asm volatile("s_waitcnt vmcnt(0)" ::: "memory");
    __syncthreads();
    if (threadIdx.x == 0) {
        unsigned* bar = b.bar;
        __builtin_amdgcn_s_waitcnt(0);
        unsigned nloc = b.st[0], nx = b.st[1];
        if (nloc == 0u) { xcd_barrier_complete(bar, b.x, nloc, nx); b.st[0] = nloc; b.st[1] = nx; }
        const unsigned old = xb_add(&bar[XB_XSUB(b.x)], 1u);
        const unsigned gen = old / nloc;
        if (old + 1u == (gen + 1u) * nloc) {
            __builtin_amdgcn_fence(__ATOMIC_RELEASE, "agent");
            asm volatile("s_waitcnt vmcnt(0)" ::: "memory");
            const unsigned og = xb_add(&bar[XB_TOP], 1u);
            const unsigned tg = og / nx;
            if (og + 1u == (tg + 1u) * nx) xb_add(&bar[XB_TOPGEN], 1u);
            else XB_SPIN(xb_ld(&bar[XB_TOPGEN]) == tg, bar);
            __builtin_amdgcn_fence(__ATOMIC_ACQUIRE, "agent");
            xb_add(&bar[XB_XGEN(b.x)], 1u);
            asm volatile("s_waitcnt vmcnt(0)" ::: "memory");
        } else {
            XB_SPIN(xb_ld(&bar[XB_XGEN(b.x)]) == gen, bar);
            __builtin_amdgcn_fence(__ATOMIC_ACQUIRE, "agent");
            asm volatile("s_waitcnt vmcnt(0)" ::: "memory");
        }
    }
    __syncthreads();
}

#ifndef NREP_PREP
#define NREP_PREP 1
#endif
#ifndef NREP_G1
#define NREP_G1 1
#endif
#ifndef NREP_D1
#define NREP_D1 1
#endif
#ifndef NREP_D2
#define NREP_D2 1
#endif
#ifndef NREP_SA
#define NREP_SA 1
#endif
#ifndef NREP_GN
#define NREP_GN 1
#endif
#ifndef NREP_MIX
#define NREP_MIX 1
#endif
#ifndef NREP_FFU
#define NREP_FFU 1
#endif
typedef const __attribute__((address_space(4))) Params* KParams;
__device__ __forceinline__ Params load_params() {
    Params r{};
#if defined(__HIP_DEVICE_COMPILE__)
    KParams kp = (KParams)__builtin_amdgcn_kernarg_segment_ptr(); asm volatile("" : "+s"(kp));
    r.x = kp->x; r.p = kp->p; r.pos = kp->pos; r.attn_norm = kp->attn_norm; r.w_in = kp->w_in; r.conv_w = kp->conv_w; r.a_log = kp->a_log; r.dt_bias = kp->dt_bias; r.dn_norm = kp->dn_norm; r.q_norm = kp->q_norm; r.k_norm = kp->k_norm;
    r.w_ba = kp->w_ba; r.w_bb = kp->w_bb; r.w_gate = kp->w_gate; r.b_gate = kp->b_gate; r.w_o = kp->w_o; r.ffn_norm = kp->ffn_norm; r.w_fg = kp->w_fg; r.w_fu = kp->w_fu; r.w_fd = kp->w_fd; r.ple_norm = kp->ple_norm; r.w_pg = kp->w_pg; r.w_ple = kp->w_ple;
    r.out = kp->out; r.ws = kp->ws;
#endif
    return r;
}
#define WSP(P, off) ((P).ws + (off))
constexpr size_t OFF_BAR = OFF_MISC + 512 * 1024;
#define GSYNC() do { const Params Pq_ = load_params(); XcdBarrier b_; b_.bar = (unsigned*)(Pq_.ws + OFF_BAR); b_.x = xb_xcc_id(); b_.st = (volatile LAS unsigned*)(shm + LDS_CTRL); xcd_barrier(b_); } while (0)
__global__ void __launch_bounds__(512, 2) mega(Params Punused) {
    extern __shared__ __attribute__((aligned(16))) unsigned char shm[];
    cg::grid_group grid = cg::this_grid();
    PG8_LAS unsigned char* lds = (PG8_LAS unsigned char*)shm; float* ldsf = (float*)shm;
    {
        volatile LAS unsigned* st = (volatile LAS unsigned*)(shm + LDS_CTRL);
        if (threadIdx.x == 0) { st[0] = 0u; st[1] = 0u; }
        __syncthreads();
        const Params P = load_params(); (void)xcd_barrier_post((unsigned*)(P.ws + OFF_BAR), st);
    }
    REP(NREP_PREP) { const Params P = load_params(); phase_prep(P, ldsf); __syncthreads(); }
    { const Params P = load_params(); if (P.ws == nullptr) grid.sync(); }
    GSYNC();
    REP(NREP_G1) { const Params P = load_params();
      run_gemm(lds, (const bf16_t*)WSP(P, OFF_R1), (const bf16_t*)WSP(P, OFF_BT1), 5120, 1024, EpiProj{(bf16_t*)WSP(P, OFF_PROJ), (float*)WSP(P, OFF_SIDE), (bf16_t*)WSP(P, OFF_GATES), P.b_gate}); }
    GSYNC();
    { const Params P = load_params(); phase_tokprep(P, shm); }
    __syncthreads();
    { const Params P = load_params(); const int wid = otid() >> 6; const int tbk = blockIdx.x + 256 * (wid >> 2);
      dn_d1(P, ((tbk >> 5) * 4 + (wid & 3)) * 32 + (tbk & 31), ldsf + wid * 4096); }
    GSYNC();
    if (blockIdx.x < 128) {
        const Params P = load_params(); dn_d2(P, shm);
        if (threadIdx.x == 0) { __builtin_amdgcn_fence(__ATOMIC_RELEASE, "agent"); asm volatile("s_waitcnt vmcnt(0)" ::: "memory"); (void)xb_add((unsigned*)(P.ws + OFF_BAR) + XCD_BAR_WORDS + 32, 1u); }
    }
    {
        const Params P = load_params();
        unsigned* qctr = (unsigned*)(P.ws + OFF_BAR) + XCD_BAR_WORDS + 16; volatile LAS unsigned* qslot = (volatile LAS unsigned*)(shm + LDS_CTRL + 16);
#pragma unroll 1
        for (;;) {
            if (threadIdx.x == 0) *qslot = __hip_atomic_fetch_add(qctr, 1u, __ATOMIC_RELAXED, __HIP_MEMORY_SCOPE_AGENT);
            __syncthreads();
            const unsigned item = *qslot;
            __syncthreads();
            if (item >= 768u) break;
            if (item < 512u) sa_block(P, (int)(item & 15u), 31 - (int)(item >> 4), shm);
            else {
                if (threadIdx.x == 0) { unsigned* dcnt = (unsigned*)(P.ws + OFF_BAR) + XCD_BAR_WORDS + 32; unsigned sp = 0; while (xb_ld(dcnt) < 128u) { __builtin_amdgcn_s_sleep(4); if (++sp > (1u << 22)) break; }
                    __builtin_amdgcn_fence(__ATOMIC_ACQUIRE, "agent"); asm volatile("s_waitcnt vmcnt(0)" ::: "memory"); }
                __syncthreads();
                phase_gnorm(P, (int)item - 512);
            }
        }
    }
    GSYNC();
    REP(NREP_MIX) { const Params P = load_params(); bf16_t* r1 = (bf16_t*)WSP(P, OFF_R1); const bf16_t* gates = (const bf16_t*)WSP(P, OFF_GATES);
      run_gemm(lds, (const bf16_t*)P.out, (const bf16_t*)WSP(P, OFF_BTA), 1024, 512, EpiMixDual{r1, gates}, (const bf16_t*)((unsigned char*)P.out + 32 * MiB), (const bf16_t*)WSP(P, OFF_BTB)); }
    GSYNC();
    { const Params P = load_params();
      run_gemm(lds, (const bf16_t*)WSP(P, OFF_R1), (const bf16_t*)WSP(P, OFF_BTO), 1024, 1024, EpiRes<1>{P.x, nullptr, (bf16_t*)WSP(P, OFF_GATES)  , (float*)WSP(P, OFF_MISC)}); }
    GSYNC();
    REP(NREP_FFU) { const Params P = load_params();
      run_gemm(lds, (const bf16_t*)WSP(P, OFF_GATES)  , (const bf16_t*)WSP(P, OFF_BTF), 5632, 1024, EpiFF{(bf16_t*)WSP(P, OFF_PROJ)  , (const float*)WSP(P, OFF_MISC)}); }
    GSYNC();
    { const Params P = load_params();
      run_gemm(lds, (const bf16_t*)WSP(P, OFF_PROJ)  , (const bf16_t*)WSP(P, OFF_BTD), 1024, 2816, EpiRes<0>{nullptr, (const bf16_t*)WSP(P, OFF_GATES)  , (bf16_t*)WSP(P, OFF_R1)  , (float*)WSP(P, OFF_MISC) + T_TOK});
      run_gemm(lds, (const bf16_t*)WSP(P, OFF_PB), (const bf16_t*)WSP(P, OFF_BTP), 1024, 256, EpiTmp{(bf16_t*)WSP(P, OFF_GATES + 64 * MiB)}); }
    GSYNC();
    { const Params P = load_params();
      run_gemm(lds, (const bf16_t*)WSP(P, OFF_R1), (const bf16_t*)WSP(P, OFF_BTPG), 1024, 1024, EpiPle{P.out, (const bf16_t*)WSP(P, OFF_R1)  , (const bf16_t*)WSP(P, OFF_GATES + 64 * MiB)  , (const float*)WSP(P, OFF_MISC) + T_TOK}); }
}

extern "C" void kernel_launch(void* const* d_in, const int* in_sizes, int n_in, void* d_out, int out_size, void* d_ws, size_t ws_size, hipStream_t stream) {
    static int grid_blocks = 0;
    if (!grid_blocks) {
        int dev = 0, cus = 0, per_cu = 0;
        hipGetDevice(&dev); hipDeviceGetAttribute(&cus, hipDeviceAttributeMultiprocessorCount, dev);
        if (hipFuncSetAttribute((const void*)mega, hipFuncAttributeMaxDynamicSharedMemorySize, LDS_BYTES) != hipSuccess) fprintf(stderr, "hipFuncSetAttribute failed\n");
        hipOccupancyMaxActiveBlocksPerMultiprocessor(&per_cu, (const void*)mega, 512, LDS_BYTES);
        if (per_cu < 1) per_cu = 1;
        grid_blocks = 256;
        if (ws_size < WS_END) fprintf(stderr, "workspace too small: %zu < %zu\n", ws_size, (size_t)WS_END);
    }
    Params P{};
    const float* const* f = (const float* const*)d_in;
    P.x = f[0]; P.p = f[1]; P.pos = (const int*)d_in[2]; P.attn_norm = f[3]; P.w_in = f[4]; P.conv_w = f[5]; P.a_log = f[6]; P.dt_bias = f[7]; P.dn_norm = f[8]; P.q_norm = f[9]; P.k_norm = f[10];
    P.w_ba = f[11]; P.w_bb = f[12]; P.w_gate = f[13]; P.b_gate = f[14]; P.w_o = f[15]; P.ffn_norm = f[16]; P.w_fg = f[17]; P.w_fu = f[18]; P.w_fd = f[19]; P.ple_norm = f[20]; P.w_pg = f[21]; P.w_ple = f[22];
    P.out = (float*)d_out; P.ws = (unsigned char*)d_ws;
    (void)hipMemsetAsync((unsigned char*)d_ws + OFF_BAR, 0, (XCD_BAR_WORDS + 64) * sizeof(unsigned), stream);
    void* args[] = {&P};
    hipError_t e = hipLaunchCooperativeKernel((const void*)mega, dim3(grid_blocks), dim3(512), args, LDS_BYTES, stream);
    if (e != hipSuccess) fprintf(stderr, "cooperative launch failed: %s (grid %d)\n", hipGetErrorString(e), grid_blocks);
}
```
